# Optimizing an MI355X kernel written in HIP

```python
import jax, jax.numpy as jnp
from jax import lax
import numpy as np

D_MODEL = 1024
BATCH = 4
SEQ = 8192
DEPTH = 4

N_MIXERS = 3
A_DILATIONS = (1, 4, 16)
A_WINDOWS = (128, 512, 2048)
A_GROUPS = 3
A_HEADS_PER_GROUP = 8
A_HEAD_DIM = 64
A_GROUP_WIDTH = A_HEADS_PER_GROUP * A_HEAD_DIM
A_STEPS = 128
A_BLOCK = 128
A_HEADS_TOTAL = A_GROUPS * A_HEADS_PER_GROUP
REL_BUCKETS = 32
REL_MAX_EXACT = REL_BUCKETS // 2
REL_MAX_DIST = 2048
B_WINDOWS = (2, 4, 8, 16)
B_GROUPS = 4
B_GROUP_WIDTH = D_MODEL // B_GROUPS
C_CHUNK = 128
C_GROUPS = 4
C_GROUP_WIDTH = D_MODEL // C_GROUPS
FFN_HIDDEN = -(-8 * D_MODEL // (3 * 256)) * 256
PLE_DIM = 256
N_A = (DEPTH + 2) // 3
N_B = (DEPTH + 1) // 3
N_C = DEPTH // 3
EPS = 1e-6
NEG = -1e30

kernel_name = "hybrid_dilated_pool_sgu_trunk"


def rmsnorm(x, g):
    xf = x.astype(jnp.float32)
    y = xf * lax.rsqrt(jnp.mean(xf * xf, axis=-1, keepdims=True) + EPS)
    return (y * g.astype(jnp.float32)).astype(x.dtype)


def t5_bucket(n):
    nf = np.maximum(n, 1).astype(np.float32)
    large = REL_MAX_EXACT + (np.log(nf / REL_MAX_EXACT) / np.log(REL_MAX_DIST / REL_MAX_EXACT)
                             * (REL_BUCKETS - REL_MAX_EXACT)).astype(np.int32)
    large = np.minimum(large, REL_BUCKETS - 1)
    return np.where(n < REL_MAX_EXACT, n, large).astype(np.int32)


def rel_bias_block(table_g, d):
    i = np.arange(A_BLOCK)[:, None]
    j = np.arange(2 * A_BLOCK)[None, :]
    rel = A_BLOCK + i - j
    valid = (rel >= 0) & (rel <= A_STEPS)
    bucket = t5_bucket(np.where(valid, rel, 0) * d)
    bias = jnp.transpose(table_g[bucket], (2, 0, 1))
    return bias, valid


def banded_branch(q, k, v, bias, valid):
    N, L, H, Dh = q.shape
    nb = -(-L // A_BLOCK)
    Lp = nb * A_BLOCK
    pad = ((0, 0), (0, Lp - L), (0, 0), (0, 0))
    qb, kb, vb = [jnp.pad(t, pad).reshape(N, nb, A_BLOCK, H, Dh) for t in (q, k, v)]

    def with_prev(t):
        prev = jnp.pad(t, ((0, 0), (1, 0), (0, 0), (0, 0), (0, 0)))[:, :-1]
        return jnp.concatenate([prev, t], axis=2)

    kk, vv = with_prev(kb), with_prev(vb)
    s = jnp.einsum('nbqhd,nbkhd->nhbqk', qb, kk).astype(jnp.float32) * (Dh ** -0.5)
    s = s + bias[:, None].astype(jnp.float32)
    key_pos = (np.arange(nb)[:, None, None] * A_BLOCK + np.arange(2 * A_BLOCK)[None, None, :] - A_BLOCK)
    mask = valid[None] & (key_pos >= 0)
    s = jnp.where(mask, s, NEG)
    m = jnp.max(s, axis=-1, keepdims=True)
    e = jnp.exp(s - m)
    den = jnp.sum(e, axis=-1, keepdims=True)
    o = jnp.einsum('nhbqk,nbkhd->nbqhd', (e / den).astype(v.dtype), vv)
    lse = (m + jnp.log(den))[..., 0]
    o = o.reshape(N, Lp, H, Dh)[:, :L]
    lse = jnp.transpose(lse, (0, 2, 3, 1)).reshape(N, Lp, H)[:, :L]
    return o, lse


def mixer_dilated(h, w_qkv, w_o, rel_table):
    B, S, _ = h.shape
    H, Dh = A_HEADS_PER_GROUP, A_HEAD_DIM
    qkv = (h @ w_qkv).reshape(B, S, 3, A_GROUPS, H, Dh)
    outs, lses = [], []
    for g, d in enumerate(A_DILATIONS):
        L = S // d

        def to_phase(t):
            return t.reshape(B, L, d, H, Dh).transpose(0, 2, 1, 3, 4).reshape(B * d, L, H, Dh)

        q, k, v = (to_phase(qkv[:, :, c, g]) for c in range(3))
        bias, valid = rel_bias_block(rel_table[:, g * H:(g + 1) * H], d)
        o, lse = banded_branch(q, k, v, bias, valid)
        outs.append(o.reshape(B, d, L, H, Dh).transpose(0, 2, 1, 3, 4).reshape(B, S, H, Dh))
        lses.append(lse.reshape(B, d, L, H).transpose(0, 2, 1, 3).reshape(B, S, H))
    w = jax.nn.softmax(jnp.stack(lses), axis=0)
    o = jnp.einsum('gbsh,gbshd->bshd', w, jnp.stack(outs).astype(jnp.float32))
    return o.reshape(B, S, A_GROUP_WIDTH).astype(h.dtype) @ w_o


def mixer_pool(h, w_in, w_grp, scale, w_out):
    B, S, _ = h.shape
    y = (h @ w_in).reshape(B, S, B_GROUPS, B_GROUP_WIDTH)
    pos = jnp.arange(1, S + 1, dtype=jnp.float32)[:, None]
    pooled = []
    for g, win in enumerate(B_WINDOWS):
        yg = y[:, :, g].astype(jnp.float32)
        c = jnp.cumsum(yg, axis=1)
        c_prev = jnp.pad(c, ((0, 0), (win, 0), (0, 0)))[:, :S]
        mean = (c - c_prev) / jnp.minimum(pos, win)
        pooled.append(mean - yg)
    z = jnp.stack(pooled, axis=2).astype(h.dtype)
    z = jnp.einsum('bsgc,gce->bsge', z, w_grp).reshape(B, S, D_MODEL) * scale
    return z @ w_out


def mixer_sgu(h, w_in, v_gain, w_s, b_s, w_out):
    B, S, _ = h.shape
    z = jax.nn.gelu(h @ w_in)
    u, v = jnp.split(z, 2, axis=-1)
    vf = v.astype(jnp.float32)
    mu = jnp.mean(vf, axis=-1, keepdims=True)
    var = jnp.mean(jnp.square(vf - mu), axis=-1, keepdims=True)
    vn = ((vf - mu) * lax.rsqrt(var + EPS) * v_gain.astype(jnp.float32)).astype(h.dtype)
    vn = vn.reshape(B, S // C_CHUNK, C_CHUNK, C_GROUPS, C_GROUP_WIDTH)
    wm = w_s * jnp.tril(jnp.ones((C_CHUNK, C_CHUNK), w_s.dtype))
    sp = jnp.einsum('gts,bnsgc->bntgc', wm, vn) + jnp.transpose(b_s)[:, :, None]
    out = u * sp.reshape(B, S, D_MODEL)
    return out @ w_out


def swiglu(h, w_gate, w_up, w_down):
    return (jax.nn.silu(h @ w_gate) * (h @ w_up)) @ w_down


def setup_inputs(seed: int = 0) -> dict:
    key = jax.random.key(seed)
    ks = jax.random.split(key, 24)
    f32 = jnp.float32

    def w(k, shape, fan_in):
        return jax.random.normal(k, shape, f32) * (fan_in ** -0.5)

    def gain(k, shape):
        return 1.0 + 0.1 * jax.random.normal(k, shape, f32)

    return {
        'x': jax.random.normal(ks[0], (BATCH, SEQ, D_MODEL), f32),
        'p': jax.random.normal(ks[1], (DEPTH, BATCH, SEQ, PLE_DIM), f32),
        'rel_table': 0.3 * jax.random.normal(ks[2], (REL_BUCKETS, A_HEADS_TOTAL), f32),
        'norm_mix': gain(ks[3], (DEPTH, D_MODEL)),
        'norm_ffn': gain(ks[4], (DEPTH, D_MODEL)),
        'norm_ple': gain(ks[5], (DEPTH, D_MODEL)),
        'final_norm': gain(ks[6], (D_MODEL,)),
        'a_w_qkv': w(ks[7], (N_A, D_MODEL, 3 * A_GROUPS * A_GROUP_WIDTH), D_MODEL),
        'a_w_o': w(ks[8], (N_A, A_GROUP_WIDTH, D_MODEL), A_GROUP_WIDTH),
        'b_w_in': w(ks[9], (N_B, D_MODEL, D_MODEL), D_MODEL),
        'b_w_grp': w(ks[10], (N_B, B_GROUPS, B_GROUP_WIDTH, B_GROUP_WIDTH), B_GROUP_WIDTH),
        'b_scale': gain(ks[11], (N_B, D_MODEL)),
        'b_w_out': w(ks[12], (N_B, D_MODEL, D_MODEL), D_MODEL),
        'c_w_in': w(ks[13], (N_C, D_MODEL, 2 * D_MODEL), D_MODEL),
        'c_v_gain': gain(ks[14], (N_C, D_MODEL)),
        'c_w_s': w(ks[15], (N_C, C_GROUPS, C_CHUNK, C_CHUNK), C_CHUNK),
        'c_b_s': gain(ks[16], (N_C, C_GROUPS, C_CHUNK)),
        'c_w_out': w(ks[17], (N_C, D_MODEL, D_MODEL), D_MODEL),
        'ffn_w_gate': w(ks[18], (DEPTH, D_MODEL, FFN_HIDDEN), D_MODEL),
        'ffn_w_up': w(ks[19], (DEPTH, D_MODEL, FFN_HIDDEN), D_MODEL),
        'ffn_w_down': w(ks[20], (DEPTH, FFN_HIDDEN, D_MODEL), FFN_HIDDEN),
        'ple_w_gate': w(ks[21], (DEPTH, D_MODEL, D_MODEL), D_MODEL),
        'ple_w_proj': w(ks[22], (DEPTH, PLE_DIM, D_MODEL), PLE_DIM),
    }


def reference(x, p, rel_table, norm_mix, norm_ffn, norm_ple, final_norm,
              a_w_qkv, a_w_o, b_w_in, b_w_grp, b_scale, b_w_out,
              c_w_in, c_v_gain, c_w_s, c_b_s, c_w_out,
              ffn_w_gate, ffn_w_up, ffn_w_down, ple_w_gate, ple_w_proj):
    h = x
    for i in range(DEPTH):
        hn = rmsnorm(h, norm_mix[i])
        kind, j = i % N_MIXERS, i // N_MIXERS
        if kind == 0:
            y = mixer_dilated(hn, a_w_qkv[j], a_w_o[j], rel_table)
        elif kind == 1:
            y = mixer_pool(hn, b_w_in[j], b_w_grp[j], b_scale[j], b_w_out[j])
        else:
            y = mixer_sgu(hn, c_w_in[j], c_v_gain[j], c_w_s[j], c_b_s[j], c_w_out[j])
        h = h + y
        h = h + swiglu(rmsnorm(h, norm_ffn[i]), ffn_w_gate[i], ffn_w_up[i], ffn_w_down[i])
        gate = jax.nn.sigmoid(rmsnorm(h, norm_ple[i]) @ ple_w_gate[i])
        h = h + (p[i] @ ple_w_proj[i]) * gate
    return rmsnorm(h, final_norm)
```

```cpp
#include <hip/hip_runtime.h>
#include <hip/hip_cooperative_groups.h>
#include <cstdio>
#include <cstdint>
namespace cg = cooperative_groups;

#ifndef MK_PER_PHASE
#define MK_PER_PHASE 0
#endif

#define LAS __attribute__((address_space(3)))
typedef unsigned short bf16_t;
typedef short bf16x8 __attribute__((ext_vector_type(8)));
typedef short s16x4 __attribute__((ext_vector_type(4)));
typedef float f32x4 __attribute__((ext_vector_type(4)));
typedef float f32x2 __attribute__((ext_vector_type(2)));
typedef unsigned u32x4 __attribute__((ext_vector_type(4)));
typedef unsigned u32x2 __attribute__((ext_vector_type(2)));

constexpr int D = 1024, BATCH = 4, SEQ = 8192, M = BATCH * SEQ, DEPTH = 4;
constexpr int NQKV = 4608, FF = 2816, PLE = 256;
constexpr float EPS = 1e-6f;
constexpr float LOG2E = 1.4426950408889634f;

__device__ __forceinline__ unsigned cvt_pk_bf16(float lo, float hi) { unsigned r; asm volatile("v_cvt_pk_bf16_f32 %0, %1, %2" : "=v"(r) : "v"(lo), "v"(hi)); return r; }
__device__ __forceinline__ float bf_lo(unsigned u) { return __uint_as_float(u << 16); }
__device__ __forceinline__ float bf_hi(unsigned u) { return __uint_as_float(u & 0xffff0000u); }
__device__ __forceinline__ float fast_exp2(float x) { return __builtin_amdgcn_exp2f(x); }
__device__ __forceinline__ float fast_rcp(float x) { return __builtin_amdgcn_rcpf(x); }
__device__ __forceinline__ float sigmoidf_(float x) { return fast_rcp(1.0f + fast_exp2(-LOG2E * x)); }
__device__ __forceinline__ float siluf_(float x) { return x * sigmoidf_(x); }
__device__ __forceinline__ float gelu_tanh(float x) { const float u = 0.7978845608028654f * (x + 0.044715f * x * x * x); return x * fast_rcp(1.0f + fast_exp2(-2.0f * LOG2E * u)); }
__device__ __forceinline__ void lds_barrier() { asm volatile("s_waitcnt lgkmcnt(0)\n\ts_barrier" ::: "memory"); }
__device__ __forceinline__ float wave_sum(float v) {
#pragma unroll
    for (int o = 1; o < 64; o <<= 1) v += __shfl_xor(v, o);
    return v;
}

template <class T> __device__ __forceinline__ T* as_global(T* p) { __attribute__((address_space(1))) T* g = (__attribute__((address_space(1))) T*)p; asm volatile("" : "+s"(g)); return (T*)g; }

namespace pg8 {
constexpr int BM = 256, BK = 64, HALF = 128, HTB = HALF * BK * 2, STAGE_BYTES = 8 * HTB, NXCD = 8, WGM = 8;
__host__ __device__ __forceinline__ int lds_byte(int r, int c) { const int st = (r >> 4) * 2 + (c >> 5), rr = r & 15, cc = c & 31, ob = rr * 64 + cc * 2; return st * 1024 + (ob ^ (((ob >> 9) & 1) << 5)); }
__host__ __device__ __forceinline__ void stage_rc(int b, int& R, int& C) { const int st = b / 1024, sb = b % 1024, swz = sb ^ (((sb >> 9) & 1) << 5); R = (st >> 1) * 16 + swz / 64; C = (st & 1) * 32 + (swz % 64) / 2; }
__host__ __device__ __forceinline__ int perm32(int rho) { const int n = rho >> 4, i = rho & 15; return 8 * (i >> 2) + 4 * n + (i & 3); }

struct Unit { int pm, pn; };
struct Gemm { const bf16_t* A; const bf16_t* Bt; int M, N, K, lda, ldb, apn; };

struct StaticOrder {
    int nM, nN, nwg, G, c;
    __device__ void init(int M_, int N_, int G_, int c_) { nM = M_ / BM; nN = N_ / BM; nwg = nM * nN; G = G_; c = c_; }
    __device__ bool next(int i, Unit& u) const {
        const long L = (long)i * G + c; if (L >= nwg) return false;
        int wgid = (int)L; { const int q = nwg / NXCD, r = nwg % NXCD, xcd = wgid % NXCD, off = wgid / NXCD; wgid = (xcd < r ? xcd * (q + 1) : r * (q + 1) + (xcd - r) * q) + off; }
        const int nig = WGM * nN, gid = wgid / nig, fm = gid * WGM, gsz = (nM - fm) < WGM ? (nM - fm) : WGM;
        u.pm = fm + ((wgid % nig) % gsz); u.pn = (wgid % nig) / gsz; return true;
    }
};

typedef unsigned long long ssq_t;
constexpr float SSQ_SCALE = 1048576.0f, SSQ_INV = 1.0f / 1048576.0f;
__device__ __forceinline__ void load_rstd(float (&rsv)[2][4], const ssq_t* ssq, int row0) {
    ssq_t t[2][4];
#pragma unroll
    for (int ai = 0; ai < 2; ++ai)
#pragma unroll
        for (int m = 0; m < 4; ++m) t[ai][m] = ssq[row0 + ai * HALF + m * 16];
#pragma unroll
    for (int ai = 0; ai < 2; ++ai)
#pragma unroll
        for (int m = 0; m < 4; ++m) rsv[ai][m] = __builtin_amdgcn_rsqf((float)t[ai][m] * (SSQ_INV / 1024.0f) + 1e-6f);
}
__device__ __forceinline__ void ssq_add(ssq_t* p, float v) { __hip_atomic_fetch_add((__attribute__((address_space(1))) ssq_t*)p, (ssq_t)(v * SSQ_SCALE), __ATOMIC_RELAXED, __HIP_MEMORY_SCOPE_AGENT); }
template <int ACT> struct EpiBf16 {
    static constexpr bool PERM = true;
    bf16_t* O; int ldc; const ssq_t* ssq;
    __device__ __forceinline__ void operator()(const f32x4 (&acc)[2][2][4][2], const Unit& u, int wr, int wc, int fr, int fq) const {
        const int row0 = u.pm * BM + wr * 64 + fr, col0 = u.pn * BM + wc * 32 + 8 * fq;
        float rsv[2][4]; load_rstd(rsv, ssq, row0);
#pragma unroll
        for (int ai = 0; ai < 2; ++ai)
#pragma unroll
            for (int m = 0; m < 4; ++m) { const int row = row0 + ai * HALF + m * 16; bf16_t* rowp = O + (size_t)row * ldc + col0; const float rs = rsv[ai][m];
#pragma unroll
                for (int bj = 0; bj < 2; ++bj) { f32x4 v0 = acc[ai][bj][m][0] * rs, v1 = acc[ai][bj][m][1] * rs;
                    if (ACT == 1) {
#pragma unroll
                        for (int j = 0; j < 4; ++j) { v0[j] = gelu_tanh(v0[j]); v1[j] = gelu_tanh(v1[j]); } }
                    u32x4 w; w.x = cvt_pk_bf16(v0[0], v0[1]); w.y = cvt_pk_bf16(v0[2], v0[3]); w.z = cvt_pk_bf16(v1[0], v1[1]); w.w = cvt_pk_bf16(v1[2], v1[3]);
                    *(u32x4*)(rowp + bj * HALF) = w; } }
    }
};
struct EpiSwiGLU {
    static constexpr bool PERM = true;
    bf16_t* O; int ldc; const ssq_t* ssq;
    __device__ __forceinline__ void operator()(const f32x4 (&acc)[2][2][4][2], const Unit& u, int wr, int wc, int fr, int fq) const {
        const int row0 = u.pm * BM + wr * 64 + fr, col0 = u.pn * HALF + wc * 32 + 8 * fq;
        float rsv[2][4]; load_rstd(rsv, ssq, row0);
#pragma unroll
        for (int ai = 0; ai < 2; ++ai)
#pragma unroll
            for (int m = 0; m < 4; ++m) { const int row = row0 + ai * HALF + m * 16; bf16_t* rowp = O + (size_t)row * ldc + col0; const float rs = rsv[ai][m];
                f32x4 v0, v1;
#pragma unroll
                for (int j = 0; j < 4; ++j) { v0[j] = siluf_(acc[ai][0][m][0][j] * rs) * (acc[ai][1][m][0][j] * rs); v1[j] = siluf_(acc[ai][0][m][1][j] * rs) * (acc[ai][1][m][1][j] * rs); }
                u32x4 w; w.x = cvt_pk_bf16(v0[0], v0[1]); w.y = cvt_pk_bf16(v0[2], v0[3]); w.z = cvt_pk_bf16(v1[0], v1[1]); w.w = cvt_pk_bf16(v1[2], v1[3]);
                *(u32x4*)rowp = w; }
    }
};
#define ER_OFF(q, bj) (off0 + (unsigned)((((q) >> 2) * HALF + ((q) & 3) * 16) * 1024 + (bj) * HALF))
#define ER_STORE(q) do { float sq = 0.f; \
            _Pragma("unroll") for (int bj = 0; bj < 2; ++bj) { const unsigned o = ER_OFF(q, bj); const f32x4 r0 = acc[(q) >> 2][bj][(q) & 3][0], r1 = acc[(q) >> 2][bj][(q) & 3][1]; \
                u32x4 w; w.x = cvt_pk_bf16(r0[0], r0[1]); w.y = cvt_pk_bf16(r0[2], r0[3]); w.z = cvt_pk_bf16(r1[0], r1[1]); w.w = cvt_pk_bf16(r1[2], r1[3]); \
                *(u32x4*)(hb + o) = w; \
                _Pragma("unroll") for (int j = 0; j < 4; ++j) { const float a = bf_lo(w[j]), b = bf_hi(w[j]); sq += a * a + b * b; } } \
            sq += __shfl_xor(sq, 16); sq += __shfl_xor(sq, 32); \
            if (fq == 0) ssq_add(ssq_out + row0 + ((q) >> 2) * HALF + ((q) & 3) * 16, sq); } while (0)
struct EpiRes {
    static constexpr bool PERM = true;
    const bf16_t* base; bf16_t* hb; ssq_t* ssq_out;
    __device__ __forceinline__ void operator()(f32x4 (&acc)[2][2][4][2], const Unit& u, int wr, int wc, int fr, int fq) const {
        const int row0 = u.pm * BM + wr * 64 + fr, col0 = u.pn * BM + wc * 32 + 8 * fq; const unsigned off0 = (unsigned)row0 * 1024u + (unsigned)col0;
        u32x4 t[4][2];
#define ER_LOAD(q) do { _Pragma("unroll") for (int bj = 0; bj < 2; ++bj) t[(q) & 3][bj] = *(const u32x4*)(base + ER_OFF(q, bj)); } while (0)
#define ER_ADD(q) do { _Pragma("unroll") for (int bj = 0; bj < 2; ++bj) { f32x4& a0 = acc[(q) >> 2][bj][(q) & 3][0]; f32x4& a1 = acc[(q) >> 2][bj][(q) & 3][1]; const u32x4 p = t[(q) & 3][bj]; \
            a0[0] += bf_lo(p.x); a0[1] += bf_hi(p.x); a0[2] += bf_lo(p.y); a0[3] += bf_hi(p.y); a1[0] += bf_lo(p.z); a1[1] += bf_hi(p.z); a1[2] += bf_lo(p.w); a1[3] += bf_hi(p.w); } } while (0)
#pragma unroll
        for (int q = 0; q < 4; ++q) ER_LOAD(q);
#pragma unroll
        for (int q = 0; q < 4; ++q) ER_ADD(q);
#pragma unroll
        for (int q = 4; q < 8; ++q) ER_LOAD(q);
#pragma unroll
        for (int q = 0; q < 4; ++q) ER_STORE(q);
#pragma unroll
        for (int q = 4; q < 8; ++q) { ER_ADD(q); ER_STORE(q); }
#undef ER_LOAD
#undef ER_ADD
    }
};
struct EpiPle {
    static constexpr bool PERM = true;
    const bf16_t* base; bf16_t* pp; const ssq_t* ssq; ssq_t* ssq_out;
    __device__ __forceinline__ void operator()(f32x4 (&acc)[2][2][4][2], const Unit& u, int wr, int wc, int fr, int fq) const {
        const int row0 = u.pm * BM + wr * 64 + fr, col0 = u.pn * BM + wc * 32 + 8 * fq; const unsigned off0 = (unsigned)row0 * 1024u + (unsigned)col0;
        float rsv[2][4]; load_rstd(rsv, ssq, row0);
        u32x4 t[2][2], pw[2][2];
#define EP_LOAD(q) do { _Pragma("unroll") for (int bj = 0; bj < 2; ++bj) { const unsigned o = ER_OFF(q, bj); t[(q) & 1][bj] = *(const u32x4*)(base + o); pw[(q) & 1][bj] = *(const u32x4*)(pp + o); } } while (0)
#define EP_ADD(q) do { _Pragma("unroll") for (int bj = 0; bj < 2; ++bj) { const float rs = rsv[(q) >> 2][(q) & 3]; const f32x4 a0 = acc[(q) >> 2][bj][(q) & 3][0] * rs, a1 = acc[(q) >> 2][bj][(q) & 3][1] * rs; const u32x4 p = pw[(q) & 1][bj], b = t[(q) & 1][bj]; f32x4 r0, r1; \
            r0[0] = bf_lo(b.x) + bf_lo(p.x) * sigmoidf_(a0[0]); r0[1] = bf_hi(b.x) + bf_hi(p.x) * sigmoidf_(a0[1]); r0[2] = bf_lo(b.y) + bf_lo(p.y) * sigmoidf_(a0[2]); r0[3] = bf_hi(b.y) + bf_hi(p.y) * sigmoidf_(a0[3]); \
            r1[0] = bf_lo(b.z) + bf_lo(p.z) * sigmoidf_(a1[0]); r1[1] = bf_hi(b.z) + bf_hi(p.z) * sigmoidf_(a1[1]); r1[2] = bf_lo(b.w) + bf_lo(p.w) * sigmoidf_(a1[2]); r1[3] = bf_hi(b.w) + bf_hi(p.w) * sigmoidf_(a1[3]); \
            acc[(q) >> 2][bj][(q) & 3][0] = r0; acc[(q) >> 2][bj][(q) & 3][1] = r1; } } while (0)
        bf16_t* hb = pp;
        EP_LOAD(0); EP_LOAD(1); EP_ADD(0); EP_ADD(1);
#pragma unroll
        for (int q = 0; q < 8; q += 2) { if (q < 6) { EP_LOAD(q + 2); EP_LOAD(q + 3); } ER_STORE(q); ER_STORE(q + 1); if (q < 6) { EP_ADD(q + 2); EP_ADD(q + 3); } }
#undef EP_LOAD
#undef EP_ADD
    }
};
#undef ER_STORE
#undef ER_OFF

template <class Epi, bool ALIGN_EPI>
__device__ __forceinline__ void gemm_phase(LAS unsigned char* lds, const Gemm g, const StaticOrder& S, const Epi& E, const int tid) {
    const int wid = __builtin_amdgcn_readfirstlane(tid >> 6), lane = tid & 63, wr = wid >> 2, wc = wid & 3, fr = lane & 15, fq = lane >> 4;
    const int K = g.K, nt = K / BK;
    unsigned voffA[2], voffB[2];
#pragma unroll
    for (int i = 0; i < 2; ++i) { int R, C; stage_rc(tid * 16 + i * 8192, R, C); const int Rb = Epi::PERM ? ((R & ~31) + perm32(R & 31)) : R;
        voffA[i] = (unsigned)(R * g.lda + C) * 2u; voffB[i] = (unsigned)(Rb * g.ldb + C) * 2u; }
    const size_t kstep = (size_t)(BK * 2);
    const size_t hA = (size_t)HALF * g.lda * 2, hB = (size_t)HALF * g.ldb * 2, tA = 2 * hA, tB = 2 * hB;
    const unsigned ldsw = (unsigned)wid * 1024u;
    const int aoff = lds_byte(wr * 64 + fr, fq * 8), boff = lds_byte(wc * 32 + fr, fq * 8);
#define PG8_SA(b, h) (((b) * 2 + (h)) * HTB)
#define PG8_SB(b, h) ((4 + (b) * 2 + (h)) * HTB)
#define PG8_STAGE(bufoff, gbase, voff) do { _Pragma("unroll") for (int _i = 0; _i < 2; ++_i) \
        __builtin_amdgcn_global_load_lds((const unsigned*)((const char*)(gbase) + (voff)[_i]), (LAS unsigned*)(lds + (bufoff) + ldsw + _i * 8192), 16, 0, 0); } while (0)
#define PG8_LDA(dst, b, h) do { _Pragma("unroll") for (int m = 0; m < 4; ++m) _Pragma("unroll") for (int k = 0; k < 2; ++k) dst[m][k] = *(const LAS bf16x8*)(lds + PG8_SA(b, h) + aoff + m * 2048 + k * 1024); } while (0)
#define PG8_LDB(dst, b, h) do { _Pragma("unroll") for (int n = 0; n < 2; ++n) _Pragma("unroll") for (int k = 0; k < 2; ++k) dst[n][k] = *(const LAS bf16x8*)(lds + PG8_SB(b, h) + boff + n * 2048 + k * 1024); } while (0)
#define PG8_MMA(ai, bj, At, Bt) do { __builtin_amdgcn_s_setprio(1); _Pragma("unroll") for (int k = 0; k < 2; ++k) _Pragma("unroll") for (int m = 0; m < 4; ++m) _Pragma("unroll") for (int n = 0; n < 2; ++n) \
        acc[ai][bj][m][n] = __builtin_amdgcn_mfma_f32_16x16x32_bf16(Bt[n][k], At[m][k], acc[ai][bj][m][n], 0, 0, 0); __builtin_amdgcn_s_setprio(0); } while (0)
#define PG8_WAIT_V(n) asm volatile("s_waitcnt vmcnt(" #n ")" ::: "memory")
#define PG8_WAIT_L(n) asm volatile("s_waitcnt lgkmcnt(" #n ")" ::: "memory")
#define PG8_BAR __builtin_amdgcn_s_barrier()
#define PG8_SCHED __builtin_amdgcn_sched_barrier(0)
    Unit cur, nxt; int ui = 0;
    if (!S.next(0, cur)) return;
    f32x4 acc[2][2][4][2];
#pragma unroll
    for (int a = 0; a < 2; ++a)
#pragma unroll
        for (int b = 0; b < 2; ++b)
#pragma unroll
            for (int m = 0; m < 4; ++m)
#pragma unroll
                for (int n = 0; n < 2; ++n) acc[a][b][m][n] = (f32x4){0.f, 0.f, 0.f, 0.f};
    bf16x8 At[4][2], B0[2][2], B1[2][2];
    const char* cA = (const char*)g.A + (size_t)cur.pm * tA + (size_t)cur.pn * g.apn * 2; const char* cB = (const char*)g.Bt + (size_t)cur.pn * tB;
    PG8_STAGE(PG8_SB(0, 0), cB, voffB); PG8_STAGE(PG8_SB(0, 1), cB + hB, voffB); PG8_STAGE(PG8_SA(0, 0), cA, voffA); PG8_STAGE(PG8_SA(0, 1), cA + hA, voffA);
    if (wr == 1) PG8_BAR;
    PG8_WAIT_V(2); PG8_BAR;
    PG8_STAGE(PG8_SB(1, 0), cB + kstep, voffB); PG8_STAGE(PG8_SA(1, 0), cA + kstep, voffA); PG8_STAGE(PG8_SB(1, 1), cB + hB + kstep, voffB);
    PG8_WAIT_V(6); PG8_BAR;
    for (;;) {
        const bool has_next = S.next(ui + 1, nxt);
        const char* nA = has_next ? (const char*)g.A + (size_t)nxt.pm * tA + (size_t)nxt.pn * g.apn * 2 : cA; const char* nB = has_next ? (const char*)g.Bt + (size_t)nxt.pn * tB : cB;
        for (int t = 0; t < nt; t += 2) {
            const bool last = (t == nt - 2);
            const char* a1 = cA + (size_t)(t + 1) * kstep;
            const char* a2 = last ? nA : cA + (size_t)(t + 2) * kstep; const char* b2 = last ? nB : cB + (size_t)(t + 2) * kstep;
            const char* a3 = a2 + kstep; const char* b3 = b2 + kstep;
            PG8_LDB(B0, 0, 0); PG8_LDB(B1, 0, 1); PG8_SCHED; PG8_LDA(At, 0, 0); PG8_STAGE(PG8_SA(1, 1), a1 + hA, voffA);
            PG8_WAIT_V(8); PG8_WAIT_L(0); PG8_BAR; PG8_MMA(0, 0, At, B0); PG8_MMA(0, 1, At, B1); PG8_BAR; PG8_SCHED;
            PG8_LDA(At, 0, 1); PG8_STAGE(PG8_SB(0, 0), b2, voffB); PG8_STAGE(PG8_SB(0, 1), b2 + hB, voffB); PG8_STAGE(PG8_SA(0, 0), a2, voffA);
            PG8_WAIT_V(8); PG8_WAIT_L(0); PG8_BAR; PG8_MMA(1, 0, At, B0); PG8_MMA(1, 1, At, B1); PG8_BAR; PG8_SCHED;
            PG8_LDB(B0, 1, 0); PG8_LDB(B1, 1, 1); PG8_SCHED; PG8_LDA(At, 1, 0); PG8_STAGE(PG8_SA(0, 1), a2 + hA, voffA);
            PG8_WAIT_V(8); PG8_WAIT_L(0); PG8_BAR; PG8_MMA(0, 0, At, B0); PG8_MMA(0, 1, At, B1); PG8_BAR; PG8_SCHED;
            PG8_LDA(At, 1, 1); PG8_STAGE(PG8_SB(1, 0), b3, voffB); PG8_STAGE(PG8_SB(1, 1), b3 + hB, voffB); PG8_STAGE(PG8_SA(1, 0), a3, voffA);
            PG8_WAIT_V(8); PG8_WAIT_L(0); PG8_BAR; PG8_MMA(1, 0, At, B0); PG8_MMA(1, 1, At, B1); PG8_BAR; PG8_SCHED;
        }
        if constexpr (ALIGN_EPI) { if (wr == 0) PG8_BAR; }
        { int t2 = tid; asm volatile("" : "+v"(t2)); const int l2 = t2 & 63, w2 = __builtin_amdgcn_readfirstlane(t2 >> 6); E(acc, cur, w2 >> 2, w2 & 3, l2 & 15, l2 >> 4); }
        if (!has_next) break;
#pragma unroll
        for (int a = 0; a < 2; ++a)
#pragma unroll
            for (int b = 0; b < 2; ++b)
#pragma unroll
                for (int m = 0; m < 4; ++m)
#pragma unroll
                    for (int n = 0; n < 2; ++n) acc[a][b][m][n] = (f32x4){0.f, 0.f, 0.f, 0.f};
        cur = nxt; cA = nA; cB = nB; ++ui;
        if constexpr (ALIGN_EPI) { if (wr == 1) PG8_BAR; }
    }
    PG8_WAIT_V(0);
    if constexpr (!ALIGN_EPI) { if (wr == 0) PG8_BAR; }
    PG8_BAR;
#undef PG8_SA
#undef PG8_SB
#undef PG8_STAGE
#undef PG8_LDA
#undef PG8_LDB
#undef PG8_MMA
#undef PG8_WAIT_V
#undef PG8_WAIT_L
#undef PG8_BAR
#undef PG8_SCHED
}
}

constexpr size_t MiB = 1u << 20;
constexpr size_t WS_BAR  = 0;
constexpr size_t WS_WQKV = 2 * MiB;
constexpr size_t WS_WO   = WS_WQKV + 18 * MiB;
constexpr size_t WS_BIN  = WS_WO + 2 * MiB;
constexpr size_t WS_BGRP = WS_BIN + 2 * MiB;
constexpr size_t WS_BOUT = WS_BGRP + MiB / 2;
constexpr size_t WS_CIN  = WS_BOUT + 2 * MiB;
constexpr size_t WS_COUT = WS_CIN + 4 * MiB;
constexpr size_t WS_WGU  = WS_COUT + 2 * MiB;
constexpr size_t WS_WDN  = WS_WGU + 44 * MiB;
constexpr size_t WS_WPG  = WS_WDN + 22 * MiB;
constexpr size_t WS_WPP  = WS_WPG + 8 * MiB;
constexpr size_t WS_X0   = WS_WPP + 2 * MiB;
constexpr size_t WS_PBF  = WS_X0 + 64 * MiB;
constexpr size_t WS_LSE  = WS_PBF + 16 * MiB;
constexpr size_t WS_BIG  = WS_LSE + 3 * MiB;
constexpr size_t WS_X1   = WS_BIG + 224 * MiB;
constexpr size_t WS_SSQ  = WS_BIG + 288 * MiB;
constexpr size_t WS_END  = WS_SSQ + 4 * MiB;
static_assert(WS_END <= 512 * MiB, "workspace map");

constexpr int LDS_BYTES = 147456;

__constant__ unsigned char c_bucket[3][132] = {
 {0,1,2,3,4,5,6,7,8,9,10,11,12,13,14,15,16,16,16,16,16,16,17,17,17,17,17,17,17,17,18,18,18,18,18,18,18,18,18,18,19,19,19,19,19,19,19,19,19,19,19,19,19,19,20,20,20,20,20,20,20,20,20,20,20,20,20,20,20,20,20,20,20,21,21,21,21,21,21,21,21,21,21,21,21,21,21,21,21,21,21,21,21,21,21,21,21,21,21,22,22,22,22,22,22,22,22,22,22,22,22,22,22,22,22,22,22,22,22,22,22,22,22,22,22,22,22,22,22,0,0,0},
 {0,4,8,12,16,16,17,17,18,18,19,19,19,19,20,20,20,20,20,21,21,21,21,21,21,22,22,22,22,22,22,22,22,22,23,23,23,23,23,23,23,23,23,23,23,23,24,24,24,24,24,24,24,24,24,24,24,24,24,24,24,24,25,25,25,25,25,25,25,25,25,25,25,25,25,25,25,25,25,25,25,25,25,26,26,26,26,26,26,26,26,26,26,26,26,26,26,26,26,26,26,26,26,26,26,26,26,26,26,26,26,26,26,27,27,27,27,27,27,27,27,27,27,27,27,27,27,27,27,0,0,0},
 {0,16,18,19,20,21,21,22,22,23,23,23,24,24,24,24,25,25,25,25,25,26,26,26,26,26,26,26,26,27,27,27,27,27,27,27,27,27,27,28,28,28,28,28,28,28,28,28,28,28,28,28,29,29,29,29,29,29,29,29,29,29,29,29,29,29,29,29,29,29,30,30,30,30,30,30,30,30,30,30,30,30,30,30,30,30,30,30,30,30,30,30,30,30,30,31,31,31,31,31,31,31,31,31,31,31,31,31,31,31,31,31,31,31,31,31,31,31,31,31,31,31,31,31,31,31,31,31,31,0,0,0}};

enum { PT_PRO = 0, PT_QKV, PT_ATTN, PT_COMB, PT_WO, PT_BIN, PT_POOL, PT_BGRP, PT_BOUT, PT_CIN, PT_SGU, PT_COUT, PT_GU, PT_DOWN, PT_PGATE, PT_FINAL };
constexpr int NPHASE = 29;
__constant__ unsigned char c_prog[NPHASE][2] = {
    {PT_PRO, 0},
    {PT_QKV, 0}, {PT_ATTN, 0}, {PT_COMB, 0}, {PT_WO, 0}, {PT_GU, 0}, {PT_DOWN, 0}, {PT_PGATE, 0},
    {PT_BIN, 1}, {PT_POOL, 1}, {PT_BGRP, 1}, {PT_BOUT, 1}, {PT_GU, 1}, {PT_DOWN, 1}, {PT_PGATE, 1},
    {PT_CIN, 2}, {PT_SGU, 2}, {PT_COUT, 2}, {PT_GU, 2}, {PT_DOWN, 2}, {PT_PGATE, 2},
    {PT_QKV, 3}, {PT_ATTN, 3}, {PT_COMB, 3}, {PT_WO, 3}, {PT_GU, 3}, {PT_DOWN, 3}, {PT_PGATE, 3},
    {PT_FINAL, 0}};
__constant__ unsigned char c_hb_in[4] = {0, 1, 0, 0}, c_hb_mid[4] = {0, 1, 1, 0};

struct Args {
    const float* in[23];
    float* out; unsigned char* ws;
    int ph_lo, ph_hi;
};
enum { I_X = 0, I_P, I_REL, I_NMIX, I_NFFN, I_NPLE, I_FNORM, I_AQKV, I_AO, I_BIN, I_BGRP, I_BSCALE, I_BOUT, I_CIN, I_CVG, I_CWS, I_CBS, I_COUT, I_FG, I_FU, I_FD, I_PG, I_PP };

template <bool KS> __device__ __forceinline__ void transpose_item(const float* W, int K, int N, bf16_t* WT, int row_off, int mode, const float* kscale, LAS float* scr, int item, int lane) {
    const int nblk = N / 32, kb = item / nblk, nb = item % nblk, k0 = 64 * kb, n0 = 32 * nb;
    f32x4 v[8]; float ks[8];
#pragma unroll
    for (int j = 0; j < 8; ++j) { const int kk = 8 * j + (lane >> 3); v[j] = *(const f32x4*)(W + (size_t)(k0 + kk) * N + n0 + 4 * (lane & 7)); ks[j] = KS ? kscale[k0 + kk] : 1.0f; }
#pragma unroll
    for (int j = 0; j < 8; ++j) { const int kk = 8 * j + (lane >> 3); LAS float* d = scr + kk * 33 + 4 * (lane & 7); d[0] = v[j].x * ks[j]; d[1] = v[j].y * ks[j]; d[2] = v[j].z * ks[j]; d[3] = v[j].w * ks[j]; }
    asm volatile("s_waitcnt lgkmcnt(0)" ::: "memory");
    const int c = lane & 7;
    int drow0 = row_off + n0;
    if (mode) drow0 = (n0 >> 7) * 256 + (n0 & 127) + (mode == 2 ? 128 : 0);
#pragma unroll
    for (int j = 0; j < 4; ++j) { const int n = (lane >> 3) + 8 * j; const LAS float* s = scr + (8 * c) * 33 + n;
        u32x4 o; o.x = cvt_pk_bf16(s[0 * 33], s[1 * 33]); o.y = cvt_pk_bf16(s[2 * 33], s[3 * 33]); o.z = cvt_pk_bf16(s[4 * 33], s[5 * 33]); o.w = cvt_pk_bf16(s[6 * 33], s[7 * 33]);
        *(u32x4*)(WT + (size_t)(drow0 + n) * K + k0 + 8 * c) = o; }
    asm volatile("s_waitcnt lgkmcnt(0)" ::: "memory");
}
struct XposeCtx { LAS float* scr; int gw, NGW, lane; unsigned base; };
template <bool KS> __device__ __forceinline__ void transpose_matrix(XposeCtx& X, const float* W, int K, int N, bf16_t* WT, int row_off, int mode, const float* kscale) {
    const int nitems = (K / 64) * (N / 32);
    const int it0 = (int)(((unsigned)X.gw + (unsigned)X.NGW - X.base % (unsigned)X.NGW) % (unsigned)X.NGW);
    for (int it = it0; it < nitems; it += X.NGW) transpose_item<KS>(W, K, N, WT, row_off, mode, kscale, X.scr, it, X.lane);
    X.base += (unsigned)nitems;
}

__device__ __forceinline__ void rmsnorm_rows(const float* h, const float* g, bf16_t* outb, float* outf, int gw, int NGW, int lane) {
    f32x4 gv[4];
#pragma unroll
    for (int j = 0; j < 4; ++j) gv[j] = ((const f32x4*)g)[64 * j + lane];
    for (int m = gw; m < M; m += NGW) {
        const f32x4* xr = (const f32x4*)(h + (size_t)m * D) + lane;
        f32x4 v[4]; float s = 0.f;
#pragma unroll
        for (int j = 0; j < 4; ++j) { v[j] = xr[64 * j]; s += (v[j].x * v[j].x + v[j].y * v[j].y) + (v[j].z * v[j].z + v[j].w * v[j].w); }
        const float rstd = 1.0f / sqrtf(wave_sum(s) * (1.0f / D) + EPS);
        if (outb) { u32x2* o8 = (u32x2*)(outb + (size_t)m * D) + lane;
#pragma unroll
            for (int j = 0; j < 4; ++j) { u32x2 w; w.x = cvt_pk_bf16(v[j].x * rstd * gv[j].x, v[j].y * rstd * gv[j].y); w.y = cvt_pk_bf16(v[j].z * rstd * gv[j].z, v[j].w * rstd * gv[j].w); o8[64 * j] = w; } }
        else { f32x4* o = (f32x4*)(outf + (size_t)m * D) + lane;
#pragma unroll
            for (int j = 0; j < 4; ++j) o[64 * j] = v[j] * rstd * gv[j]; }
    }
}
__device__ __forceinline__ void final_rows(const bf16_t* hb, const float* g, float* outf, int gw, int NGW, int lane) {
    f32x4 gv[4];
#pragma unroll
    for (int j = 0; j < 4; ++j) gv[j] = ((const f32x4*)g)[64 * j + lane];
    for (int m0 = gw; m0 < M; m0 += 4 * NGW) {
        u32x2 w[4][4];
#pragma unroll
        for (int r = 0; r < 4; ++r) { const int m = m0 + r * NGW < M ? m0 + r * NGW : M - 1; const u32x2* xr = (const u32x2*)(hb + (size_t)m * D) + lane;
#pragma unroll
            for (int j = 0; j < 4; ++j) w[r][j] = xr[64 * j]; }
#pragma unroll
        for (int r = 0; r < 4; ++r) { const int m = m0 + r * NGW; f32x4 v[4]; float s = 0.f;
#pragma unroll
            for (int j = 0; j < 4; ++j) { v[j] = (f32x4){bf_lo(w[r][j].x), bf_hi(w[r][j].x), bf_lo(w[r][j].y), bf_hi(w[r][j].y)}; s += (v[j].x * v[j].x + v[j].y * v[j].y) + (v[j].z * v[j].z + v[j].w * v[j].w); }
            const float rstd = 1.0f / sqrtf(wave_sum(s) * (1.0f / D) + EPS);
            if (m < M) { f32x4* o = (f32x4*)(outf + (size_t)m * D) + lane;
#pragma unroll
                for (int j = 0; j < 4; ++j) o[64 * j] = v[j] * rstd * gv[j]; } }
    }
}
__device__ __forceinline__ void convert_p(const float* p, bf16_t* pb, int gtid, int NT) {
    const size_t n8 = (size_t)M * PLE / 8;
    for (size_t i0 = gtid; i0 < n8; i0 += (size_t)4 * NT) {
        f32x4 a[4], b[4];
#pragma unroll
        for (int r = 0; r < 4; ++r) { const size_t i = i0 + (size_t)r * NT < n8 ? i0 + (size_t)r * NT : n8 - 1; a[r] = ((const f32x4*)p)[2 * i]; b[r] = ((const f32x4*)p)[2 * i + 1]; }
#pragma unroll
        for (int r = 0; r < 4; ++r) { const size_t i = i0 + (size_t)r * NT; if (i < n8) { u32x4 w; w.x = cvt_pk_bf16(a[r].x, a[r].y); w.y = cvt_pk_bf16(a[r].z, a[r].w); w.z = cvt_pk_bf16(b[r].x, b[r].y); w.w = cvt_pk_bf16(b[r].z, b[r].w); ((u32x4*)pb)[i] = w; } }
    }
}

constexpr int ATT_K = 0, ATT_V = 49152, ATT_LUT = 98304;
__device__ __forceinline__ int kswz(int row) { return (((row >> 1) & 3) << 1) | ((row >> 3) & 1); }
struct AttnGeom { int g, h, d, qt, N0, qcol; size_t tok0; };
__device__ __forceinline__ AttnGeom attn_geom(int unit) {
    AttnGeom a; const int idx = unit & 1023, rest = idx >> 3, b = rest >> 5, wq = rest & 31;
    a.g = unit >> 10; a.h = idx & 7; const int sh = 2 * a.g, tpp = 32 >> sh; a.d = 1 << sh;
    const int r = wq / tpp; a.qt = wq % tpp; a.N0 = a.qt * 256; a.tok0 = (size_t)b * SEQ + r; a.qcol = a.g * 512 + a.h * 64; return a;
}
__device__ __forceinline__ void attn_fetch(const bf16_t* QKV, const AttnGeom& a, int tid, u32x4 (&kr)[6], u32x4 (&vr)[6], bf16x8 (&qf)[2][2]) {
    const int lane = tid & 63, w = tid >> 6, fr = lane & 15, G = lane >> 4;
#pragma unroll
    for (int i = 0; i < 6; ++i) { const int ix = tid + 512 * i, row = ix >> 3, ch = ix & 7; int step = a.N0 - 128 + row; step = step < 0 ? 0 : step;
        const bf16_t* rp = QKV + (a.tok0 + (size_t)step * a.d) * NQKV + a.qcol + ch * 8; kr[i] = *(const u32x4*)(rp + 1536); vr[i] = *(const u32x4*)(rp + 3072); }
#pragma unroll
    for (int qi = 0; qi < 2; ++qi) { const bf16_t* qp = QKV + (a.tok0 + (size_t)(a.N0 + 32 * w + 16 * qi + fr) * a.d) * NQKV + a.qcol + 8 * G;
        qf[qi][0] = *(const bf16x8*)qp; qf[qi][1] = *(const bf16x8*)(qp + 32); }
}
__device__ __forceinline__ void attn_phase(bf16_t* QKV, bf16_t* OG, float* LSE, const float* rel_table, LAS unsigned char* lds, int bx, int Gd, int tid) {
    const int lane = tid & 63, w = __builtin_amdgcn_readfirstlane(tid >> 6), fr = lane & 15, G = lane >> 4;
    {   int bk[9]; float tv[9];
#pragma unroll
        for (int k = 0; k < 9; ++k) { const int e = tid + 512 * k, gh = e / 192, rel = e - gh * 192 - 31; const int rc = rel < 0 ? 0 : (rel > 128 ? 128 : rel); bk[k] = (int)c_bucket[gh >> 3][rc] * 24 + gh; }
#pragma unroll
        for (int k = 0; k < 9; ++k) tv[k] = rel_table[bk[k]];
#pragma unroll
        for (int k = 0; k < 9; ++k) { const int e = tid + 512 * k, gh = e / 192, rel = e - gh * 192 - 31; ((LAS float*)(lds + ATT_LUT))[e] = (rel >= 0 && rel <= 128) ? tv[k] * LOG2E : -1e30f; }
    }
    u32x4 kr[6], vr[6]; bf16x8 qn[2][2];
    int unit = bx; AttnGeom a = attn_geom(unit);
    if (unit < 3072) attn_fetch(QKV, a, tid, kr, vr, qn);
    const float c1 = 0.125f * LOG2E;
    const int q4 = fr >> 2, p4 = fr & 3;
    for (; unit < 3072; unit += Gd) {
#pragma unroll
        for (int i = 0; i < 6; ++i) { const int ix = tid + 512 * i, row = ix >> 3, ch = ix & 7; const bool neg = (a.N0 - 128 + row) < 0;
            const u32x4 z = (u32x4){0u, 0u, 0u, 0u};
            *(LAS u32x4*)(lds + ATT_K + row * 128 + ((ch ^ kswz(row)) * 16)) = neg ? z : kr[i];
            { const int yv = (row >> 1) & 3; u32x4 vv = neg ? z : vr[i]; if (yv & 1) vv = (u32x4){vv.z, vv.w, vv.x, vv.y};
              *(LAS u32x4*)(lds + ATT_V + row * 128 + (ch >> 1) * 32 + (((ch & 1) ^ (yv >> 1)) * 16)) = vv; } }
        bf16x8 qf[2][2];
#pragma unroll
        for (int qi = 0; qi < 2; ++qi) { qf[qi][0] = qn[qi][0]; qf[qi][1] = qn[qi][1]; }
        const AttnGeom c = a;
        lds_barrier();
        { const int nu = unit + Gd; if (nu < 3072) { a = attn_geom(nu); attn_fetch(QKV, a, tid, kr, vr, qn); } }
        f32x4 O[2][4]; float mrun[2], lsum[2];
#pragma unroll
        for (int qi = 0; qi < 2; ++qi) { mrun[qi] = -1e29f; lsum[qi] = 0.f;
#pragma unroll
            for (int cc = 0; cc < 4; ++cc) O[qi][cc] = (f32x4){0.f, 0.f, 0.f, 0.f}; }
        const LAS float* lut = (const LAS float*)(lds + ATT_LUT) + (c.g * 8 + c.h) * 192;
#pragma unroll 1
        for (int c5 = 0; c5 < 5; ++c5) {
            const int kbase = 32 * w + 32 * c5;
            bf16x8 kf[2][2];
#pragma unroll
            for (int kt = 0; kt < 2; ++kt) { const int row = kbase + 16 * kt + fr;
#pragma unroll
                for (int s2 = 0; s2 < 2; ++s2) kf[kt][s2] = *(const LAS bf16x8*)(lds + ATT_K + row * 128 + (((G + 4 * s2) ^ kswz(row)) * 16)); }
            bf16x8 vf[4];
#pragma unroll
            for (int cc = 0; cc < 4; ++cc) {
                const int r0 = kbase + 4 * G + q4, r1 = r0 + 16;
                const s16x4 lo = __builtin_bit_cast(s16x4, __builtin_amdgcn_ds_read_tr16_b64_v4i16((LAS s16x4*)(lds + ATT_V + r0 * 128 + p4 * 32 + ((cc ^ ((r0 >> 1) & 3)) * 8))));
                const s16x4 hi = __builtin_bit_cast(s16x4, __builtin_amdgcn_ds_read_tr16_b64_v4i16((LAS s16x4*)(lds + ATT_V + r1 * 128 + p4 * 32 + ((cc ^ ((r1 >> 1) & 3)) * 8))));
                vf[cc] = (bf16x8){lo[0], lo[1], lo[2], lo[3], hi[0], hi[1], hi[2], hi[3]}; }
            const bool edge = (c.qt == 0) && (kbase < 128);
#pragma unroll
            for (int qi = 0; qi < 2; ++qi) {
                f32x4 S[2];
#pragma unroll
                for (int kt = 0; kt < 2; ++kt) { S[kt] = __builtin_amdgcn_mfma_f32_16x16x32_bf16(kf[kt][0], qf[qi][0], (f32x4){0.f, 0.f, 0.f, 0.f}, 0, 0, 0);
                    S[kt] = __builtin_amdgcn_mfma_f32_16x16x32_bf16(kf[kt][1], qf[qi][1], S[kt], 0, 0, 0); }
                float mx = -1e30f;
#pragma unroll
                for (int kt = 0; kt < 2; ++kt)
#pragma unroll
                    for (int i = 0; i < 4; ++i) { const int li = 159 + 16 * qi + fr - 4 * G - 32 * c5 - 16 * kt - i;
                        float sv = S[kt][i] * c1 + lut[li];
                        if (edge && (kbase + 16 * kt + 4 * G + i) < 128) sv = -1e30f;
                        S[kt][i] = sv; mx = fmaxf(mx, sv); }
                mx = fmaxf(mx, __shfl_xor(mx, 16)); mx = fmaxf(mx, __shfl_xor(mx, 32));
                const float mnew = fmaxf(mrun[qi], mx), alpha = fast_exp2(mrun[qi] - mnew); mrun[qi] = mnew;
                float ps = 0.f;
#pragma unroll
                for (int kt = 0; kt < 2; ++kt)
#pragma unroll
                    for (int i = 0; i < 4; ++i) { const float p = fast_exp2(S[kt][i] - mnew); S[kt][i] = p; ps += p; }
                lsum[qi] = lsum[qi] * alpha + ps;
                u32x4 pw; pw.x = cvt_pk_bf16(S[0][0], S[0][1]); pw.y = cvt_pk_bf16(S[0][2], S[0][3]); pw.z = cvt_pk_bf16(S[1][0], S[1][1]); pw.w = cvt_pk_bf16(S[1][2], S[1][3]);
                const bf16x8 pf = __builtin_bit_cast(bf16x8, pw);
#pragma unroll
                for (int cc = 0; cc < 4; ++cc) { O[qi][cc] = O[qi][cc] * alpha; O[qi][cc] = __builtin_amdgcn_mfma_f32_16x16x32_bf16(vf[cc], pf, O[qi][cc], 0, 0, 0); }
            }
        }
#pragma unroll
        for (int qi = 0; qi < 2; ++qi) {
            float l = lsum[qi]; l += __shfl_xor(l, 16); l += __shfl_xor(l, 32);
            const float inv = 1.0f / l;
            const size_t tok = c.tok0 + (size_t)(c.N0 + 32 * w + 16 * qi + fr) * c.d;
            bf16_t* op = OG + ((size_t)unit * 256 + (32 * w + 16 * qi + fr)) * 64 + 16 * G;
#pragma unroll
            for (int hh = 0; hh < 2; ++hh) { u32x4 o; o.x = cvt_pk_bf16(O[qi][2 * hh][0] * inv, O[qi][2 * hh][1] * inv); o.y = cvt_pk_bf16(O[qi][2 * hh][2] * inv, O[qi][2 * hh][3] * inv);
                o.z = cvt_pk_bf16(O[qi][2 * hh + 1][0] * inv, O[qi][2 * hh + 1][1] * inv); o.w = cvt_pk_bf16(O[qi][2 * hh + 1][2] * inv, O[qi][2 * hh + 1][3] * inv); *(u32x4*)(op + 8 * hh) = o; }
            if (G == 0) LSE[(tok * 3 + c.g) * 8 + c.h] = mrun[qi] + __log2f(l);
        }
        lds_barrier();
    }
}
__device__ __forceinline__ void attn_combine(bf16_t* QKV, const bf16_t* OG, const float* LSE, int gtid, int NT) {
    for (int ix0 = gtid; ix0 < M * 64; ix0 += 4 * NT) {
        float l[4][3]; u32x4 a[4][3];
#pragma unroll
        for (int r = 0; r < 4; ++r) { const int ix = ix0 + r * NT < M * 64 ? ix0 + r * NT : M * 64 - 1; const int tok = ix >> 6, h = (ix >> 3) & 7, ch = ix & 7;
            const int bb = tok >> 13, t = tok & (SEQ - 1);
#pragma unroll
            for (int g = 0; g < 3; ++g) { l[r][g] = LSE[((size_t)tok * 3 + g) * 8 + h];
                const int sh = 2 * g, rr = t & ((1 << sh) - 1), n = t >> sh, unit = g * 1024 + ((bb * 32 + (rr * (32 >> sh) + (n >> 8))) * 8 + h);
                a[r][g] = *(const u32x4*)(OG + ((size_t)unit * 256 + (n & 255)) * 64 + ch * 8); } }
#pragma unroll
        for (int r = 0; r < 4; ++r) { const int ix = ix0 + r * NT; const int tok = ix >> 6, h = (ix >> 3) & 7, ch = ix & 7;
            const float mx = fmaxf(l[r][0], fmaxf(l[r][1], l[r][2])); float w0 = fast_exp2(l[r][0] - mx), w1 = fast_exp2(l[r][1] - mx), w2 = fast_exp2(l[r][2] - mx); const float inv = 1.0f / (w0 + w1 + w2); w0 *= inv; w1 *= inv; w2 *= inv;
            u32x4 o;
#pragma unroll
            for (int j = 0; j < 4; ++j) { const float lo = w0 * bf_lo(a[r][0][j]) + w1 * bf_lo(a[r][1][j]) + w2 * bf_lo(a[r][2][j]), hi = w0 * bf_hi(a[r][0][j]) + w1 * bf_hi(a[r][1][j]) + w2 * bf_hi(a[r][2][j]); o[j] = cvt_pk_bf16(lo, hi); }
            if (ix < M * 64) *(u32x4*)(QKV + (size_t)tok * NQKV + 1536 + h * 64 + ch * 8) = o; }
    }
}

template <int WIN> __device__ __forceinline__ void pool_strip(const bf16_t* Y, bf16_t* Z, int t0, int col) {
    const int spos0 = t0 & (SEQ - 1);
    u32x4 r[WIN + 7];
#pragma unroll
    for (int i = 0; i < WIN + 7; ++i) { const int rel = i - (WIN - 1); const bool ok = spos0 + rel >= 0; const int tok = ok ? t0 + rel : t0;
        r[i] = *(const u32x4*)(Y + (size_t)tok * D + col); if (!ok) r[i] = (u32x4){0u, 0u, 0u, 0u}; }
    float S[8];
#pragma unroll
    for (int c = 0; c < 8; ++c) S[c] = 0.f;
#pragma unroll
    for (int i = 0; i < WIN - 1; ++i)
#pragma unroll
        for (int c = 0; c < 4; ++c) { S[2 * c] += bf_lo(r[i][c]); S[2 * c + 1] += bf_hi(r[i][c]); }
#pragma unroll
    for (int j = 0; j < 8; ++j) { const u32x4 y = r[WIN - 1 + j];
#pragma unroll
        for (int c = 0; c < 4; ++c) { S[2 * c] += bf_lo(y[c]); S[2 * c + 1] += bf_hi(y[c]); }
        const int n = (spos0 + j + 1) < WIN ? (spos0 + j + 1) : WIN; const float inv = 1.0f / (float)n; u32x4 o;
#pragma unroll
        for (int c = 0; c < 4; ++c) o[c] = cvt_pk_bf16(S[2 * c] * inv - bf_lo(y[c]), S[2 * c + 1] * inv - bf_hi(y[c]));
        *(u32x4*)(Z + (size_t)(t0 + j) * D + col) = o;
        const u32x4 q = r[j];
#pragma unroll
        for (int c = 0; c < 4; ++c) { S[2 * c] -= bf_lo(q[c]); S[2 * c + 1] -= bf_hi(q[c]); } }
}
__device__ __forceinline__ void pool_phase(const bf16_t* Y, bf16_t* Z, int gw, int NGW, int lane) {
    for (int it = gw; it < (M / 16) * 4; it += NGW) { const int g = it & 3, sp = it >> 2; const int t0 = (sp * 2 + (lane >> 5)) * 8, col = g * 256 + (lane & 31) * 8;
        if (g == 0) pool_strip<2>(Y, Z, t0, col); else if (g == 1) pool_strip<4>(Y, Z, t0, col); else if (g == 2) pool_strip<8>(Y, Z, t0, col); else pool_strip<16>(Y, Z, t0, col); }
}

constexpr int SG_VN = 0, SG_WM = 65536, SG_ST = 98304;
__device__ __forceinline__ void sgu_unit(const bf16_t* Zc, bf16_t* Gt, const float* vgain, const float* w_s, const float* b_s, LAS unsigned char* lds, int chunk, int tid) {
    const int lane = tid & 63, w = __builtin_amdgcn_readfirstlane(tid >> 6), fr = lane & 15, G = lane >> 4;
    const size_t t0 = (size_t)chunk * 128;
    LAS float* st = (LAS float*)(lds + SG_ST);
    for (int i0 = 0; i0 < 16; i0 += 4) {
        u32x4 a[4], b2[4];
#pragma unroll
        for (int r = 0; r < 4; ++r) { const u32x4* vp = (const u32x4*)(Zc + (t0 + 16 * w + i0 + r) * 2048 + 1024) + lane; a[r] = vp[0]; b2[r] = vp[64]; }
#pragma unroll
        for (int r = 0; r < 4; ++r) { const int t = 16 * w + i0 + r; float x[16];
#pragma unroll
            for (int j = 0; j < 4; ++j) { x[2 * j] = bf_lo(a[r][j]); x[2 * j + 1] = bf_hi(a[r][j]); x[8 + 2 * j] = bf_lo(b2[r][j]); x[9 + 2 * j] = bf_hi(b2[r][j]); }
            float sm = 0.f;
#pragma unroll
            for (int j = 0; j < 16; ++j) sm += x[j];
            const float mu = wave_sum(sm) * (1.0f / 1024.0f); float q = 0.f;
#pragma unroll
            for (int j = 0; j < 16; ++j) { const float dd = x[j] - mu; q += dd * dd; }
            const float rstd = 1.0f / sqrtf(wave_sum(q) * (1.0f / 1024.0f) + EPS);
            if (lane == 0) { st[2 * t] = mu; st[2 * t + 1] = rstd; } }
    }
    lds_barrier();
    for (int g = 0; g < 4; ++g) {
#pragma unroll
        for (int i = 0; i < 8; ++i) { const int ix = tid + 512 * i, s = ix >> 5, ch = ix & 31, c0 = g * 256 + ch * 8;
            const u32x4 a = *(const u32x4*)(Zc + (t0 + s) * 2048 + 1024 + c0); const f32x4 g0 = *(const f32x4*)(vgain + c0), g1 = *(const f32x4*)(vgain + c0 + 4);
            const float mu = st[2 * s], rs = st[2 * s + 1]; u32x4 o;
            o.x = cvt_pk_bf16((bf_lo(a.x) - mu) * rs * g0.x, (bf_hi(a.x) - mu) * rs * g0.y); o.y = cvt_pk_bf16((bf_lo(a.y) - mu) * rs * g0.z, (bf_hi(a.y) - mu) * rs * g0.w);
            o.z = cvt_pk_bf16((bf_lo(a.z) - mu) * rs * g1.x, (bf_hi(a.z) - mu) * rs * g1.y); o.w = cvt_pk_bf16((bf_lo(a.w) - mu) * rs * g1.z, (bf_hi(a.w) - mu) * rs * g1.w);
            const int sw = (s & 3) | (((s >> 3) & 1) << 2);
            *(LAS u32x4*)(lds + SG_VN + s * 512 + ((((ch >> 1) ^ sw)) * 32) + (ch & 1) * 16) = o; }
#pragma unroll
        for (int i = 0; i < 4; ++i) { const int ix = tid + 512 * i, t = ix >> 4, ch = ix & 15, s0 = ch * 8;
            const float* wp = w_s + ((size_t)g * 128 + t) * 128 + s0; const f32x4 a = *(const f32x4*)wp, b2 = *(const f32x4*)(wp + 4); float x[8] = {a.x, a.y, a.z, a.w, b2.x, b2.y, b2.z, b2.w};
#pragma unroll
            for (int j = 0; j < 8; ++j) if (s0 + j > t) x[j] = 0.f;
            u32x4 o; o.x = cvt_pk_bf16(x[0], x[1]); o.y = cvt_pk_bf16(x[2], x[3]); o.z = cvt_pk_bf16(x[4], x[5]); o.w = cvt_pk_bf16(x[6], x[7]);
            *(LAS u32x4*)(lds + SG_WM + t * 256 + ((ch ^ (t & 15)) * 16)) = o; }
        lds_barrier();
        f32x4 acc[2][8];
#pragma unroll
        for (int ct = 0; ct < 2; ++ct)
#pragma unroll
            for (int tt = 0; tt < 8; ++tt) acc[ct][tt] = (f32x4){0.f, 0.f, 0.f, 0.f};
        const int q4 = fr >> 2, p4 = fr & 3;
#pragma unroll
        for (int sc = 0; sc < 4; ++sc) {
            bf16x8 af[2];
#pragma unroll
            for (int ct = 0; ct < 2; ++ct) { const int r0 = 32 * sc + 8 * G + q4, r1 = r0 + 4, u32 = 2 * w + ct;
                const int sw0 = (r0 & 3) | (((r0 >> 3) & 1) << 2), sw1 = (r1 & 3) | (((r1 >> 3) & 1) << 2);
                const s16x4 lo = __builtin_bit_cast(s16x4, __builtin_amdgcn_ds_read_tr16_b64_v4i16((LAS s16x4*)(lds + SG_VN + r0 * 512 + ((u32 ^ sw0) * 32) + 8 * p4)));
                const s16x4 hi = __builtin_bit_cast(s16x4, __builtin_amdgcn_ds_read_tr16_b64_v4i16((LAS s16x4*)(lds + SG_VN + r1 * 512 + ((u32 ^ sw1) * 32) + 8 * p4)));
                af[ct] = (bf16x8){lo[0], lo[1], lo[2], lo[3], hi[0], hi[1], hi[2], hi[3]}; }
#pragma unroll
            for (int tt = 0; tt < 8; ++tt) { const int t = 16 * tt + fr; const bf16x8 bfr = *(const LAS bf16x8*)(lds + SG_WM + t * 256 + (((4 * sc + G) ^ (t & 15)) * 16));
#pragma unroll
                for (int ct = 0; ct < 2; ++ct) acc[ct][tt] = __builtin_amdgcn_mfma_f32_16x16x32_bf16(af[ct], bfr, acc[ct][tt], 0, 0, 0); }
        }
#pragma unroll
        for (int tt = 0; tt < 8; ++tt) { const int t = 16 * tt + fr; const float bs = b_s[g * 128 + t];
#pragma unroll
            for (int ct = 0; ct < 2; ++ct) { const int c = g * 256 + 32 * w + 16 * ct + 4 * G; const u32x2 uu = *(const u32x2*)(Zc + (t0 + t) * 2048 + c);
                u32x2 o; o.x = cvt_pk_bf16(bf_lo(uu.x) * (acc[ct][tt][0] + bs), bf_hi(uu.x) * (acc[ct][tt][1] + bs)); o.y = cvt_pk_bf16(bf_lo(uu.y) * (acc[ct][tt][2] + bs), bf_hi(uu.y) * (acc[ct][tt][3] + bs));
                *(u32x2*)(Gt + (t0 + t) * 1024 + c) = o; } }
        lds_barrier();
    }
}

#define XB_TMO      128
#define XB_XCNT(j)  (256  + 64 * (j))
#define XB_XSUB(j)  (1280 + 64 * (j))
#define XB_XGEN(j)  (2304 + 64 * (j))
#define XB_TOP      3328
#define XB_TOPGEN   3392
#define XCD_BAR_WORDS 3456
#define XB_SPIN_CAP (1u << 18)

__device__ __forceinline__ unsigned xb_ld(unsigned* p)              { return __hip_atomic_load(p, __ATOMIC_RELAXED, __HIP_MEMORY_SCOPE_AGENT); }
__device__ __forceinline__ unsigned xb_add(unsigned* p, unsigned v) { return __hip_atomic_fetch_add(p, v, __ATOMIC_RELAXED, __HIP_MEMORY_SCOPE_AGENT); }
__device__ __forceinline__ unsigned xb_xcc_id() { return (unsigned)__builtin_amdgcn_s_getreg((3 << 11) | 20) & 0xFu; }
#define XB_SPIN(cond, bar) do { unsigned _sp = 0; while (cond) { __builtin_amdgcn_s_sleep(1); \
    if ((++_sp & 255u) == 0u) { if (xb_ld(&(bar)[XB_TMO])) break; if (_sp > XB_SPIN_CAP) { atomicAdd(&(bar)[XB_TMO], 1u); break; } } } } while (0)

struct XcdBarrier {
    unsigned* bar; unsigned x;
    volatile LAS unsigned* st;
};

__device__ __forceinline__ XcdBarrier xcd_barrier_post(unsigned* bar, volatile LAS unsigned* st) {
    XcdBarrier b; b.bar = bar; b.x = xb_xcc_id(); b.st = st;
    if (threadIdx.x == 0) (void)xb_add(&bar[XB_XCNT(b.x)], 1u);
    return b;
}
__device__ __forceinline__ void xcd_barrier_complete(unsigned* bar, unsigned x, unsigned& nloc, unsigned& nx) {
    const unsigned G = gridDim.x * gridDim.y * gridDim.z;
    unsigned sum, cnt, mine, sp = 0u;
    for (;;) {
        sum = 0u; cnt = 0u; mine = 0u;
#pragma unroll
        for (unsigned j = 0; j < 16; ++j) { const unsigned c = xb_ld(&bar[XB_XCNT(j)]); sum += c; cnt += (c > 0u) ? 1u : 0u; mine = (j == x) ? c : mine; }
        if (sum == G) break;
        __builtin_amdgcn_s_sleep(1);
        if ((++sp & 255u) == 0u) { if (xb_ld(&bar[XB_TMO])) break; if (sp > XB_SPIN_CAP) { atomicAdd(&bar[XB_TMO], 1u); break; } }
    }
    nloc = mine > 0u ? mine : 1u; nx = cnt > 0u ? cnt : 1u;
}

__device__ __forceinline__ void xcd_barrier(const XcdBarrier& b) {
    asm volatile("s_waitcnt vmcnt(0)" ::: "memory");
    __syncthreads();
    if (threadIdx.x == 0) {
        unsigned* bar = b.bar;
        __builtin_amdgcn_s_waitcnt(0);
        unsigned nloc = b.st[0], nx = b.st[1];
        if (nloc == 0u) { xcd_barrier_complete(bar, b.x, nloc, nx); b.st[0] = nloc; b.st[1] = nx; }
        const unsigned old = xb_add(&bar[XB_XSUB(b.x)], 1u);
        const unsigned gen = old / nloc;
        if (old + 1u == (gen + 1u) * nloc) {
            __builtin_amdgcn_fence(__ATOMIC_RELEASE, "agent");
            asm volatile("s_waitcnt vmcnt(0)" ::: "memory");
            const unsigned og = xb_add(&bar[XB_TOP], 1u);
            const unsigned tg = og / nx;
            if (og + 1u == (tg + 1u) * nx) xb_add(&bar[XB_TOPGEN], 1u);
            else XB_SPIN(xb_ld(&bar[XB_TOPGEN]) == tg, bar);
            __builtin_amdgcn_fence(__ATOMIC_ACQUIRE, "agent");
            xb_add(&bar[XB_XGEN(b.x)], 1u);
            asm volatile("s_waitcnt vmcnt(0)" ::: "memory");
        } else {
            XB_SPIN(xb_ld(&bar[XB_XGEN(b.x)]) == gen, bar);
            __builtin_amdgcn_fence(__ATOMIC_ACQUIRE, "agent");
            asm volatile("s_waitcnt vmcnt(0)" ::: "memory");
        }
    }
    __syncthreads();
}

__device__ __forceinline__ void x_rows(const float* x, bf16_t* xb, pg8::ssq_t* ssq, int gw, int NGW, int lane) {
    for (int m0 = gw; m0 < M; m0 += 4 * NGW) {
        f32x4 v[4][4];
#pragma unroll
        for (int r = 0; r < 4; ++r) { const int m = m0 + r * NGW < M ? m0 + r * NGW : M - 1; const f32x4* xr = (const f32x4*)(x + (size_t)m * D) + lane;
#pragma unroll
            for (int j = 0; j < 4; ++j) v[r][j] = xr[64 * j]; }
#pragma unroll
        for (int r = 0; r < 4; ++r) { const int m = m0 + r * NGW; float s = 0.f;
#pragma unroll
            for (int j = 0; j < 4; ++j) s += (v[r][j].x * v[r][j].x + v[r][j].y * v[r][j].y) + (v[r][j].z * v[r][j].z + v[r][j].w * v[r][j].w);
            s = wave_sum(s);
            if (m < M) { u32x2* o8 = (u32x2*)(xb + (size_t)m * D) + lane;
#pragma unroll
                for (int j = 0; j < 4; ++j) { u32x2 w; w.x = cvt_pk_bf16(v[r][j].x, v[r][j].y); w.y = cvt_pk_bf16(v[r][j].z, v[r][j].w); o8[64 * j] = w; }
                if (lane == 0) ssq[m] = (pg8::ssq_t)(s * pg8::SSQ_SCALE); } }
    }
}

__global__ void __launch_bounds__(512, 2) fwd_kernel(Args args) {
    extern __shared__ __attribute__((aligned(16))) unsigned char lds_raw[];
    LAS unsigned char* lds = (LAS unsigned char*)lds_raw;
    if (threadIdx.x < 16) ((LAS unsigned*)(lds + 131072))[threadIdx.x] = 0u;
    __syncthreads();
    XcdBarrier xbar; xbar.bar = (unsigned*)(args.ws + WS_BAR); xbar.x = 0; xbar.st = (volatile LAS unsigned*)(lds + 131072);
    for (int ph = args.ph_lo; ph < args.ph_hi; ++ph) {
        const __attribute__((address_space(4))) Args* ap = (const __attribute__((address_space(4))) Args*)__builtin_amdgcn_kernarg_segment_ptr(); asm volatile("" : "+s"(ap));
        int tid = threadIdx.x; asm volatile("" : "+v"(tid));
        const int lane = tid & 63, wave = __builtin_amdgcn_readfirstlane(tid >> 6);
        int Gd = gridDim.x, bx = blockIdx.x; asm volatile("" : "+s"(Gd), "+s"(bx));
        const int gw = bx * 8 + wave, NGW = Gd * 8, gtid = bx * 512 + tid, NT = Gd * 512;
        unsigned char* ws = ap->ws; asm volatile("" : "+s"(ws)); ws = as_global(ws);
        bf16_t* PBF = (bf16_t*)(ws + WS_PBF); float* LSE = (float*)(ws + WS_LSE); bf16_t* BIG = (bf16_t*)(ws + WS_BIG);
        pg8::ssq_t* SSQ = (pg8::ssq_t*)(ws + WS_SSQ);
        float* H = as_global(ap->out);
        const int type = c_prog[ph][0], layer = c_prog[ph][1];
        bf16_t* HBin = (bf16_t*)(ws + (c_hb_in[layer] ? WS_X1 : WS_X0)); bf16_t* HBmid = (bf16_t*)(ws + (c_hb_mid[layer] ? WS_X1 : WS_X0)); bf16_t* HBoth = (bf16_t*)(ws + (c_hb_mid[layer] ? WS_X0 : WS_X1));
        pg8::Gemm gm{nullptr, nullptr, M, 0, 0, 0, 0, 0}; int epi = -1; bf16_t* ob = nullptr; int ldc = 0; const pg8::ssq_t* ssq_in = SSQ + (size_t)13 * M; pg8::ssq_t* ssq_out = nullptr; bf16_t* hbo = nullptr; const bf16_t* hbase = nullptr;
        bool second = false; bool conv_p = false;
        switch (type) {
#ifndef DIS_PRO
        case PT_PRO: {
            if (bx == 0 && ph == 0) for (int i = tid; i < XCD_BAR_WORDS; i += 512) ((unsigned*)(ws + WS_BAR))[i] = 0u;
            unsigned cz = 0u, co = 1073740750u; asm volatile("" : "+v"(cz), "+v"(co));
            for (int i = gtid; i < 12 * M / 2; i += NT) ((u32x4*)(SSQ + M))[i] = (u32x4){cz, cz, cz, cz};
            for (int i = gtid; i < M / 2; i += NT) ((u32x4*)(SSQ + (size_t)13 * M))[i] = (u32x4){co, cz, co, cz};
            XposeCtx X{(LAS float*)(lds + wave * 16384), gw, NGW, lane, 0u};
            for (int j = 0; j < 2; ++j) {
                transpose_matrix<true>(X, as_global(ap->in[I_AQKV]) + (size_t)j * D * NQKV, D, NQKV, (bf16_t*)(ws + WS_WQKV) + (size_t)j * NQKV * D, 0, 0, as_global(ap->in[I_NMIX]) + (j ? 3 : 0) * D);
                transpose_matrix<false>(X, as_global(ap->in[I_AO]) + (size_t)j * 512 * D, 512, D, (bf16_t*)(ws + WS_WO) + (size_t)j * D * 512, 0, 0, nullptr);
            }
            transpose_matrix<true>(X, as_global(ap->in[I_BIN]), D, D, (bf16_t*)(ws + WS_BIN), 0, 0, as_global(ap->in[I_NMIX]) + 1 * D);
            for (int g = 0; g < 4; ++g) transpose_matrix<false>(X, as_global(ap->in[I_BGRP]) + (size_t)g * 65536, 256, 256, (bf16_t*)(ws + WS_BGRP), g * 256, 0, nullptr);
            transpose_matrix<true>(X, as_global(ap->in[I_BOUT]), D, D, (bf16_t*)(ws + WS_BOUT), 0, 0, as_global(ap->in[I_BSCALE]));
            transpose_matrix<true>(X, as_global(ap->in[I_CIN]), D, 2048, (bf16_t*)(ws + WS_CIN), 0, 0, as_global(ap->in[I_NMIX]) + 2 * D);
            transpose_matrix<false>(X, as_global(ap->in[I_COUT]), D, D, (bf16_t*)(ws + WS_COUT), 0, 0, nullptr);
            for (int i = 0; i < DEPTH; ++i) {
                transpose_matrix<true>(X, as_global(ap->in[I_FG]) + (size_t)i * D * FF, D, FF, (bf16_t*)(ws + WS_WGU) + (size_t)i * 2 * FF * D, 0, 1, as_global(ap->in[I_NFFN]) + i * D);
                transpose_matrix<true>(X, as_global(ap->in[I_FU]) + (size_t)i * D * FF, D, FF, (bf16_t*)(ws + WS_WGU) + (size_t)i * 2 * FF * D, 0, 2, as_global(ap->in[I_NFFN]) + i * D);
                transpose_matrix<false>(X, as_global(ap->in[I_FD]) + (size_t)i * FF * D, FF, D, (bf16_t*)(ws + WS_WDN) + (size_t)i * D * FF, 0, 0, nullptr);
                transpose_matrix<true>(X, as_global(ap->in[I_PG]) + (size_t)i * D * D, D, D, (bf16_t*)(ws + WS_WPG) + (size_t)i * D * D, 0, 0, as_global(ap->in[I_NPLE]) + i * D);
                transpose_matrix<false>(X, as_global(ap->in[I_PP]) + (size_t)i * PLE * D, PLE, D, (bf16_t*)(ws + WS_WPP) + (size_t)i * D * PLE, 0, 0, nullptr);
            }
            x_rows(as_global(ap->in[I_X]), (bf16_t*)(ws + WS_X0), SSQ, gw, NGW, lane);
            convert_p(as_global(ap->in[I_P]), PBF, gtid, NT);
        } break;
#endif
        case PT_FINAL: final_rows((const bf16_t*)(ws + WS_X1), as_global(ap->in[I_FNORM]), H, gw, NGW, lane); break;
        case PT_QKV: gm.A = HBin; gm.Bt = (bf16_t*)(ws + WS_WQKV) + (size_t)(layer / 3) * NQKV * D; gm.N = NQKV; gm.K = D; gm.lda = D; gm.ldb = D; epi = 0; ob = BIG; ldc = NQKV; ssq_in = SSQ + (size_t)(3 * layer) * M; conv_p = layer > 0; break;
#ifndef DIS_ATTN
        case PT_ATTN: attn_phase(BIG, (bf16_t*)H, LSE, as_global(ap->in[I_REL]), lds, bx, Gd, tid); break;
#endif
        case PT_COMB: attn_combine(BIG, (const bf16_t*)H, LSE, gtid, NT); break;
        case PT_WO: gm.A = BIG + 1536; gm.Bt = (bf16_t*)(ws + WS_WO) + (size_t)(layer / 3) * D * 512; gm.N = D; gm.K = 512; gm.lda = NQKV; gm.ldb = 512; epi = 3; hbo = HBmid; ssq_out = SSQ + (size_t)(3 * layer + 1) * M; hbase = HBin; break;
        case PT_BIN: gm.A = HBin; gm.Bt = (bf16_t*)(ws + WS_BIN); gm.N = D; gm.K = D; gm.lda = D; gm.ldb = D; epi = 0; ob = BIG; ldc = D; ssq_in = SSQ + (size_t)(3 * layer) * M; conv_p = true; break;
        case PT_POOL: pool_phase(BIG, BIG + (size_t)M * D, gw, NGW, lane); break;
        case PT_BGRP: gm.A = BIG + (size_t)M * D; gm.Bt = (bf16_t*)(ws + WS_BGRP); gm.N = D; gm.K = 256; gm.lda = D; gm.ldb = 256; gm.apn = 256; epi = 0; ob = BIG + (size_t)2 * M * D; ldc = D; break;
        case PT_BOUT: gm.A = BIG + (size_t)2 * M * D; gm.Bt = (bf16_t*)(ws + WS_BOUT); gm.N = D; gm.K = D; gm.lda = D; gm.ldb = D; epi = 3; hbo = HBmid; ssq_out = SSQ + (size_t)(3 * layer + 1) * M; hbase = HBin; break;
        case PT_CIN: gm.A = HBin; gm.Bt = (bf16_t*)(ws + WS_CIN); gm.N = 2048; gm.K = D; gm.lda = D; gm.ldb = D; epi = 1; ob = BIG; ldc = 2048; ssq_in = SSQ + (size_t)(3 * layer) * M; conv_p = true; break;
#ifndef DIS_SGU
        case PT_SGU: for (int u = bx; u < M / 128; u += Gd) sgu_unit(BIG, BIG + (size_t)M * 2048, as_global(ap->in[I_CVG]), as_global(ap->in[I_CWS]), as_global(ap->in[I_CBS]), lds, u, tid); break;
#endif
        case PT_COUT: gm.A = BIG + (size_t)M * 2048; gm.Bt = (bf16_t*)(ws + WS_COUT); gm.N = D; gm.K = D; gm.lda = D; gm.ldb = D; epi = 3; hbo = HBmid; ssq_out = SSQ + (size_t)(3 * layer + 1) * M; hbase = HBin; break;
        case PT_GU: gm.A = HBmid; gm.Bt = (bf16_t*)(ws + WS_WGU) + (size_t)layer * 2 * FF * D; gm.N = 2 * FF; gm.K = D; gm.lda = D; gm.ldb = D; epi = 2; ob = BIG; ldc = FF; ssq_in = SSQ + (size_t)(3 * layer + 1) * M; break;
        case PT_DOWN: gm.A = BIG; gm.Bt = (bf16_t*)(ws + WS_WDN) + (size_t)layer * D * FF; gm.N = D; gm.K = FF; gm.lda = FF; gm.ldb = FF; epi = 3; hbo = HBmid; ssq_out = SSQ + (size_t)(3 * layer + 2) * M; second = true; hbase = HBmid; break;
        case PT_PGATE: gm.A = HBmid; gm.Bt = (bf16_t*)(ws + WS_WPG) + (size_t)layer * D * D; gm.N = D; gm.K = D; gm.lda = D; gm.ldb = D; epi = 4; ssq_in = SSQ + (size_t)(3 * layer + 2) * M; ssq_out = SSQ + (size_t)(3 * layer + 3) * M; break;
        default: break;
        }
#ifndef DIS_GEMM
        if (epi >= 0) {
            pg8::StaticOrder S; S.init(M, gm.N, Gd, bx);
#ifdef ONLY_EPI
            if (epi != ONLY_EPI) epi = 99;
#endif
            if (epi == 99) {} else
            if (epi == 0) { pg8::EpiBf16<0> E{ob, ldc, ssq_in}; pg8::gemm_phase<pg8::EpiBf16<0>, true>(lds, gm, S, E, tid); }
            else if (epi == 1) { pg8::EpiBf16<1> E{ob, ldc, ssq_in}; pg8::gemm_phase<pg8::EpiBf16<1>, true>(lds, gm, S, E, tid); }
            else if (epi == 2) { pg8::EpiSwiGLU E{ob, ldc, ssq_in}; pg8::gemm_phase<pg8::EpiSwiGLU, true>(lds, gm, S, E, tid); }
            else if (epi == 3) { pg8::EpiRes E{hbase, hbo, ssq_out}; pg8::gemm_phase<pg8::EpiRes, false>(lds, gm, S, E, tid); }
            else { pg8::EpiPle E{HBmid, HBoth, ssq_in, ssq_out}; pg8::gemm_phase<pg8::EpiPle, false>(lds, gm, S, E, tid); }
        }
        if (second) {
            pg8::Gemm g2{PBF, (bf16_t*)(ws + WS_WPP) + (size_t)layer * D * PLE, M, D, PLE, PLE, PLE, 0};
            pg8::StaticOrder S; S.init(M, D, Gd, bx);
            pg8::EpiBf16<0> E{HBoth, D, SSQ + (size_t)13 * M}; pg8::gemm_phase<pg8::EpiBf16<0>, true>(lds, g2, S, E, tid);
        }
#endif
        if (conv_p) convert_p(as_global(ap->in[I_P]) + (size_t)layer * M * PLE, PBF, gtid, NT);
        if (ph + 1 < args.ph_hi) {
            if (ph == 0) { cg::this_grid().sync(); xbar = xcd_barrier_post((unsigned*)(args.ws + WS_BAR), (volatile LAS unsigned*)(lds + 131072)); }
            else xcd_barrier(xbar);
        }
    }
}

extern "C" void kernel_launch(void* const* d_in, const int* in_sizes, int n_in, void* d_out, int out_size, void* d_ws, size_t ws_size, hipStream_t stream) {
    static int grid = 0;
    if (grid == 0) {
        if (n_in != 23 || out_size != M * D || ws_size < WS_END) { fprintf(stderr, "kernel_launch: unexpected problem (n_in %d, out %d, ws %zu < %zu)\n", n_in, out_size, ws_size, (size_t)WS_END); grid = -1; return; }
        int dev = 0, cus = 0, per_cu = 0;
        hipGetDevice(&dev); hipDeviceGetAttribute(&cus, hipDeviceAttributeMultiprocessorCount, dev);
        if (hipFuncSetAttribute((const void*)fwd_kernel, hipFuncAttributeMaxDynamicSharedMemorySize, LDS_BYTES) != hipSuccess) { fprintf(stderr, "kernel_launch: hipFuncSetAttribute failed\n"); grid = -1; return; }
        if (hipOccupancyMaxActiveBlocksPerMultiprocessor(&per_cu, (const void*)fwd_kernel, 512, LDS_BYTES) != hipSuccess || per_cu < 1) { fprintf(stderr, "kernel_launch: occupancy query says %d blocks/CU\n", per_cu); per_cu = 1; }
        (void)hipGetLastError();
        grid = cus;
    }
    if (grid < 0) return;
    Args a{};
    for (int i = 0; i < 23; ++i) a.in[i] = (const float*)d_in[i];
    a.out = (float*)d_out; a.ws = (unsigned char*)d_ws;
#if MK_PER_PHASE
    for (int ph = 0; ph < NPHASE; ++ph) { a.ph_lo = ph; a.ph_hi = ph + 1; hipLaunchKernelGGL(fwd_kernel, dim3(grid), dim3(512), LDS_BYTES, stream, a); }
#else
    a.ph_lo = 0; a.ph_hi = NPHASE;
    void* kargs[] = {&a};
    hipError_t e = hipLaunchCooperativeKernel((const void*)fwd_kernel, dim3(grid), dim3(512), kargs, LDS_BYTES, stream);
    if (e != hipSuccess) fprintf(stderr, "cooperative launch failed: %s (grid %d)\n", hipGetErrorString(e), grid);
#endif
}
```

```cpp
#include <hip/hip_runtime.h>
#include <hip/hip_cooperative_groups.h>
#include <cstdio>
#include <cstdint>
namespace cg = cooperative_groups;

#ifndef MK_PER_PHASE
#define MK_PER_PHASE 0
#endif

#define LAS __attribute__((address_space(3)))
typedef unsigned short bf16_t;
typedef short bf16x8 __attribute__((ext_vector_type(8)));
typedef short s16x4 __attribute__((ext_vector_type(4)));
typedef float f32x4 __attribute__((ext_vector_type(4)));
typedef float f32x2 __attribute__((ext_vector_type(2)));
typedef unsigned u32x4 __attribute__((ext_vector_type(4)));
typedef unsigned u32x2 __attribute__((ext_vector_type(2)));

constexpr int D = 1024, BATCH = 4, SEQ = 8192, M = BATCH * SEQ, DEPTH = 4;
constexpr int NQKV = 4608, FF = 2816, PLE = 256;
constexpr float EPS = 1e-6f;
constexpr float LOG2E = 1.4426950408889634f;

__device__ __forceinline__ unsigned cvt_pk_bf16(float lo, float hi) { unsigned r; asm volatile("v_cvt_pk_bf16_f32 %0, %1, %2" : "=v"(r) : "v"(lo), "v"(hi)); return r; }
__device__ __forceinline__ float bf_lo(unsigned u) { return __uint_as_float(u << 16); }
__device__ __forceinline__ float bf_hi(unsigned u) { return __uint_as_float(u & 0xffff0000u); }
__device__ __forceinline__ float fast_exp2(float x) { return __builtin_amdgcn_exp2f(x); }
__device__ __forceinline__ float fast_rcp(float x) { return __builtin_amdgcn_rcpf(x); }
__device__ __forceinline__ float sigmoidf_(float x) { return fast_rcp(1.0f + fast_exp2(-LOG2E * x)); }
__device__ __forceinline__ float siluf_(float x) { return x * sigmoidf_(x); }
__device__ __forceinline__ float gelu_tanh(float x) { const float u = 0.7978845608028654f * (x + 0.044715f * x * x * x); return x * fast_rcp(1.0f + fast_exp2(-2.0f * LOG2E * u)); }
__device__ __forceinline__ void lds_barrier() { asm volatile("s_waitcnt lgkmcnt(0)\n\ts_barrier" ::: "memory"); }
__device__ __forceinline__ float wave_sum(float v) {
#pragma unroll
    for (int o = 1; o < 64; o <<= 1) v += __shfl_xor(v, o);
    return v;
}

template <class T> __device__ __forceinline__ T* as_global(T* p) { __attribute__((address_space(1))) T* g = (__attribute__((address_space(1))) T*)p; asm volatile("" : "+s"(g)); return (T*)g; }

namespace pg8 {
constexpr int BM = 256, BK = 64, HALF = 128, HTB = HALF * BK * 2, STAGE_BYTES = 8 * HTB, NXCD = 8, WGM = 8;
__host__ __device__ __forceinline__ int lds_byte(int r, int c) { const int st = (r >> 4) * 2 + (c >> 5), rr = r & 15, cc = c & 31, ob = rr * 64 + cc * 2; return st * 1024 + (ob ^ (((ob >> 9) & 1) << 5)); }
__host__ __device__ __forceinline__ void stage_rc(int b, int& R, int& C) { const int st = b / 1024, sb = b % 1024, swz = sb ^ (((sb >> 9) & 1) << 5); R = (st >> 1) * 16 + swz / 64; C = (st & 1) * 32 + (swz % 64) / 2; }
__host__ __device__ __forceinline__ int perm32(int rho) { const int n = rho >> 4, i = rho & 15; return 8 * (i >> 2) + 4 * n + (i & 3); }

struct Unit { int pm, pn; };
struct Gemm { const bf16_t* A; const bf16_t* Bt; int M, N, K, lda, ldb, apn; };

struct StaticOrder {
    int nM, nN, nwg, G, c;
    __device__ void init(int M_, int N_, int G_, int c_) { nM = M_ / BM; nN = N_ / BM; nwg = nM * nN; G = G_; c = c_; }
    __device__ bool next(int i, Unit& u) const {
        const long L = (long)i * G + c; if (L >= nwg) return false;
        int wgid = (int)L; { const int q = nwg / NXCD, r = nwg % NXCD, xcd = wgid % NXCD, off = wgid / NXCD; wgid = (xcd < r ? xcd * (q + 1) : r * (q + 1) + (xcd - r) * q) + off; }
        const int nig = WGM * nN, gid = wgid / nig, fm = gid * WGM, gsz = (nM - fm) < WGM ? (nM - fm) : WGM;
        u.pm = fm + ((wgid % nig) % gsz); u.pn = (wgid % nig) / gsz; return true;
    }
};

typedef unsigned long long ssq_t;
constexpr float SSQ_SCALE = 1048576.0f, SSQ_INV = 1.0f / 1048576.0f;
__device__ __forceinline__ void load_rstd(float (&rsv)[2][4], const ssq_t* ssq, int row0) {
    ssq_t t[2][4];
#pragma unroll
    for (int ai = 0; ai < 2; ++ai)
#pragma unroll
        for (int m = 0; m < 4; ++m) t[ai][m] = ssq[row0 + ai * HALF + m * 16];
#pragma unroll
    for (int ai = 0; ai < 2; ++ai)
#pragma unroll
        for (int m = 0; m < 4; ++m) rsv[ai][m] = __builtin_amdgcn_rsqf((float)t[ai][m] * (SSQ_INV / 1024.0f) + 1e-6f);
}
__device__ __forceinline__ void ssq_add(ssq_t* p, float v) { __hip_atomic_fetch_add((__attribute__((address_space(1))) ssq_t*)p, (ssq_t)(v * SSQ_SCALE), __ATOMIC_RELAXED, __HIP_MEMORY_SCOPE_AGENT); }
template <int ACT> struct EpiBf16 {
    static constexpr bool PERM = true;
    bf16_t* O; int ldc; const ssq_t* ssq;
    __device__ __forceinline__ void operator()(const f32x4 (&acc)[2][2][4][2], const Unit& u, int wr, int wc, int fr, int fq) const {
        const int row0 = u.pm * BM + wr * 64 + fr, col0 = u.pn * BM + wc * 32 + 8 * fq;
        float rsv[2][4]; load_rstd(rsv, ssq, row0);
#pragma unroll
        for (int ai = 0; ai < 2; ++ai)
#pragma unroll
            for (int m = 0; m < 4; ++m) { const int row = row0 + ai * HALF + m * 16; bf16_t* rowp = O + (size_t)row * ldc + col0; const float rs = rsv[ai][m];
#pragma unroll
                for (int bj = 0; bj < 2; ++bj) { f32x4 v0 = acc[ai][bj][m][0] * rs, v1 = acc[ai][bj][m][1] * rs;
                    if (ACT == 1) {
#pragma unroll
                        for (int j = 0; j < 4; ++j) { v0[j] = gelu_tanh(v0[j]); v1[j] = gelu_tanh(v1[j]); } }
                    u32x4 w; w.x = cvt_pk_bf16(v0[0], v0[1]); w.y = cvt_pk_bf16(v0[2], v0[3]); w.z = cvt_pk_bf16(v1[0], v1[1]); w.w = cvt_pk_bf16(v1[2], v1[3]);
                    *(u32x4*)(rowp + bj * HALF) = w; } }
    }
};
struct EpiSwiGLU {
    static constexpr bool PERM = true;
    bf16_t* O; int ldc; const ssq_t* ssq;
    __device__ __forceinline__ void operator()(const f32x4 (&acc)[2][2][4][2], const Unit& u, int wr, int wc, int fr, int fq) const {
        const int row0 = u.pm * BM + wr * 64 + fr, col0 = u.pn * HALF + wc * 32 + 8 * fq;
        float rsv[2][4]; load_rstd(rsv, ssq, row0);
#pragma unroll
        for (int ai = 0; ai < 2; ++ai)
#pragma unroll
            for (int m = 0; m < 4; ++m) { const int row = row0 + ai * HALF + m * 16; bf16_t* rowp = O + (size_t)row * ldc + col0; const float rs = rsv[ai][m];
                f32x4 v0, v1;
#pragma unroll
                for (int j = 0; j < 4; ++j) { v0[j] = siluf_(acc[ai][0][m][0][j] * rs) * (acc[ai][1][m][0][j] * rs); v1[j] = siluf_(acc[ai][0][m][1][j] * rs) * (acc[ai][1][m][1][j] * rs); }
                u32x4 w; w.x = cvt_pk_bf16(v0[0], v0[1]); w.y = cvt_pk_bf16(v0[2], v0[3]); w.z = cvt_pk_bf16(v1[0], v1[1]); w.w = cvt_pk_bf16(v1[2], v1[3]);
                *(u32x4*)rowp = w; }
    }
};
#define ER_OFF(q, bj) (off0 + (unsigned)((((q) >> 2) * HALF + ((q) & 3) * 16) * 1024 + (bj) * HALF))
#define ER_STORE(q) do { float sq = 0.f; \
            _Pragma("unroll") for (int bj = 0; bj < 2; ++bj) { const unsigned o = ER_OFF(q, bj); const f32x4 r0 = acc[(q) >> 2][bj][(q) & 3][0], r1 = acc[(q) >> 2][bj][(q) & 3][1]; \
                u32x4 w; w.x = cvt_pk_bf16(r0[0], r0[1]); w.y = cvt_pk_bf16(r0[2], r0[3]); w.z = cvt_pk_bf16(r1[0], r1[1]); w.w = cvt_pk_bf16(r1[2], r1[3]); \
                *(u32x4*)(hb + o) = w; \
                _Pragma("unroll") for (int j = 0; j < 4; ++j) { const float a = bf_lo(w[j]), b = bf_hi(w[j]); sq += a * a + b * b; } } \
            sq += __shfl_xor(sq, 16); sq += __shfl_xor(sq, 32); \
            if (fq == 0) ssq_add(ssq_out + row0 + ((q) >> 2) * HALF + ((q) & 3) * 16, sq); } while (0)
struct EpiRes {
    static constexpr bool PERM = true;
    const bf16_t* base; bf16_t* hb; ssq_t* ssq_out;
    __device__ __forceinline__ void operator()(f32x4 (&acc)[2][2][4][2], const Unit& u, int wr, int wc, int fr, int fq) const {
        const int row0 = u.pm * BM + wr * 64 + fr, col0 = u.pn * BM + wc * 32 + 8 * fq; const unsigned off0 = (unsigned)row0 * 1024u + (unsigned)col0;
        u32x4 t[4][2];
#define ER_LOAD(q) do { _Pragma("unroll") for (int bj = 0; bj < 2; ++bj) t[(q) & 3][bj] = *(const u32x4*)(base + ER_OFF(q, bj)); } while (0)
#define ER_ADD(q) do { _Pragma("unroll") for (int bj = 0; bj < 2; ++bj) { f32x4& a0 = acc[(q) >> 2][bj][(q) & 3][0]; f32x4& a1 = acc[(q) >> 2][bj][(q) & 3][1]; const u32x4 p = t[(q) & 3][bj]; \
            a0[0] += bf_lo(p.x); a0[1] += bf_hi(p.x); a0[2] += bf_lo(p.y); a0[3] += bf_hi(p.y); a1[0] += bf_lo(p.z); a1[1] += bf_hi(p.z); a1[2] += bf_lo(p.w); a1[3] += bf_hi(p.w); } } while (0)
#pragma unroll
        for (int q = 0; q < 4; ++q) ER_LOAD(q);
#pragma unroll
        for (int q = 0; q < 4; ++q) ER_ADD(q);
#pragma unroll
        for (int q = 4; q < 8; ++q) ER_LOAD(q);
#pragma unroll
        for (int q = 0; q < 4; ++q) ER_STORE(q);
#pragma unroll
        for (int q = 4; q < 8; ++q) { ER_ADD(q); ER_STORE(q); }
#undef ER_LOAD
#undef ER_ADD
    }
};
struct EpiPle {
    static constexpr bool PERM = true;
    const bf16_t* base; bf16_t* pp; const ssq_t* ssq; ssq_t* ssq_out;
    __device__ __forceinline__ void operator()(f32x4 (&acc)[2][2][4][2], const Unit& u, int wr, int wc, int fr, int fq) const {
        const int row0 = u.pm * BM + wr * 64 + fr, col0 = u.pn * BM + wc * 32 + 8 * fq; const unsigned off0 = (unsigned)row0 * 1024u + (unsigned)col0;
        float rsv[2][4]; load_rstd(rsv, ssq, row0);
        u32x4 t[2][2], pw[2][2];
#define EP_LOAD(q) do { _Pragma("unroll") for (int bj = 0; bj < 2; ++bj) { const unsigned o = ER_OFF(q, bj); t[(q) & 1][bj] = *(const u32x4*)(base + o); pw[(q) & 1][bj] = *(const u32x4*)(pp + o); } } while (0)
#define EP_ADD(q) do { _Pragma("unroll") for (int bj = 0; bj < 2; ++bj) { const float rs = rsv[(q) >> 2][(q) & 3]; const f32x4 a0 = acc[(q) >> 2][bj][(q) & 3][0] * rs, a1 = acc[(q) >> 2][bj][(q) & 3][1] * rs; const u32x4 p = pw[(q) & 1][bj], b = t[(q) & 1][bj]; f32x4 r0, r1; \
            r0[0] = bf_lo(b.x) + bf_lo(p.x) * sigmoidf_(a0[0]); r0[1] = bf_hi(b.x) + bf_hi(p.x) * sigmoidf_(a0[1]); r0[2] = bf_lo(b.y) + bf_lo(p.y) * sigmoidf_(a0[2]); r0[3] = bf_hi(b.y) + bf_hi(p.y) * sigmoidf_(a0[3]); \
            r1[0] = bf_lo(b.z) + bf_lo(p.z) * sigmoidf_(a1[0]); r1[1] = bf_hi(b.z) + bf_hi(p.z) * sigmoidf_(a1[1]); r1[2] = bf_lo(b.w) + bf_lo(p.w) * sigmoidf_(a1[2]); r1[3] = bf_hi(b.w) + bf_hi(p.w) * sigmoidf_(a1[3]); \
            acc[(q) >> 2][bj][(q) & 3][0] = r0; acc[(q) >> 2][bj][(q) & 3][1] = r1; } } while (0)
        bf16_t* hb = pp;
        EP_LOAD(0); EP_LOAD(1); EP_ADD(0); EP_ADD(1);
#pragma unroll
        for (int q = 0; q < 8; q += 2) { if (q < 6) { EP_LOAD(q + 2); EP_LOAD(q + 3); } ER_STORE(q); ER_STORE(q + 1); if (q < 6) { EP_ADD(q + 2); EP_ADD(q + 3); } }
#undef EP_LOAD
#undef EP_ADD
    }
};
#undef ER_STORE
#undef ER_OFF

template <class Epi, bool ALIGN_EPI>
__device__ __forceinline__ void gemm_phase(LAS unsigned char* lds, const Gemm g, const StaticOrder& S, const Epi& E, const int tid) {
    const int wid = __builtin_amdgcn_readfirstlane(tid >> 6), lane = tid & 63, wr = wid >> 2, wc = wid & 3, fr = lane & 15, fq = lane >> 4;
    const int K = g.K, nt = K / BK;
    unsigned voffA[2], voffB[2];
#pragma unroll
    for (int i = 0; i < 2; ++i) { int R, C; stage_rc(tid * 16 + i * 8192, R, C); const int Rb = Epi::PERM ? ((R & ~31) + perm32(R & 31)) : R;
        voffA[i] = (unsigned)(R * g.lda + C) * 2u; voffB[i] = (unsigned)(Rb * g.ldb + C) * 2u; }
    const size_t kstep = (size_t)(BK * 2);
    const size_t hA = (size_t)HALF * g.lda * 2, hB = (size_t)HALF * g.ldb * 2, tA = 2 * hA, tB = 2 * hB;
    const unsigned ldsw = (unsigned)wid * 1024u;
    const int aoff = lds_byte(wr * 64 + fr, fq * 8), boff = lds_byte(wc * 32 + fr, fq * 8);
#define PG8_SA(b, h) (((b) * 2 + (h)) * HTB)
#define PG8_SB(b, h) ((4 + (b) * 2 + (h)) * HTB)
#define PG8_STAGE(bufoff, gbase, voff) do { _Pragma("unroll") for (int _i = 0; _i < 2; ++_i) \
        __builtin_amdgcn_global_load_lds((const unsigned*)((const char*)(gbase) + (voff)[_i]), (LAS unsigned*)(lds + (bufoff) + ldsw + _i * 8192), 16, 0, 0); } while (0)
#define PG8_LDA(dst, b, h) do { _Pragma("unroll") for (int m = 0; m < 4; ++m) _Pragma("unroll") for (int k = 0; k < 2; ++k) dst[m][k] = *(const LAS bf16x8*)(lds + PG8_SA(b, h) + aoff + m * 2048 + k * 1024); } while (0)
#define PG8_LDB(dst, b, h) do { _Pragma("unroll") for (int n = 0; n < 2; ++n) _Pragma("unroll") for (int k = 0; k < 2; ++k) dst[n][k] = *(const LAS bf16x8*)(lds + PG8_SB(b, h) + boff + n * 2048 + k * 1024); } while (0)
#define PG8_MMA(ai, bj, At, Bt) do { __builtin_amdgcn_s_setprio(1); _Pragma("unroll") for (int k = 0; k < 2; ++k) _Pragma("unroll") for (int m = 0; m < 4; ++m) _Pragma("unroll") for (int n = 0; n < 2; ++n) \
        acc[ai][bj][m][n] = __builtin_amdgcn_mfma_f32_16x16x32_bf16(Bt[n][k], At[m][k], acc[ai][bj][m][n], 0, 0, 0); __builtin_amdgcn_s_setprio(0); } while (0)
#define PG8_WAIT_V(n) asm volatile("s_waitcnt vmcnt(" #n ")" ::: "memory")
#define PG8_WAIT_L(n) asm volatile("s_waitcnt lgkmcnt(" #n ")" ::: "memory")
#define PG8_BAR __builtin_amdgcn_s_barrier()
#define PG8_SCHED __builtin_amdgcn_sched_barrier(0)
    Unit cur, nxt; int ui = 0;
    if (!S.next(0, cur)) return;
    f32x4 acc[2][2][4][2];
#pragma unroll
    for (int a = 0; a < 2; ++a)
#pragma unroll
        for (int b = 0; b < 2; ++b)
#pragma unroll
            for (int m = 0; m < 4; ++m)
#pragma unroll
                for (int n = 0; n < 2; ++n) acc[a][b][m][n] = (f32x4){0.f, 0.f, 0.f, 0.f};
    bf16x8 At[4][2], B0[2][2], B1[2][2];
    const char* cA = (const char*)g.A + (size_t)cur.pm * tA + (size_t)cur.pn * g.apn * 2; const char* cB = (const char*)g.Bt + (size_t)cur.pn * tB;
    PG8_STAGE(PG8_SB(0, 0), cB, voffB); PG8_STAGE(PG8_SB(0, 1), cB + hB, voffB); PG8_STAGE(PG8_SA(0, 0), cA, voffA); PG8_STAGE(PG8_SA(0, 1), cA + hA, voffA);
    if (wr == 1) PG8_BAR;
    PG8_WAIT_V(2); PG8_BAR;
    PG8_STAGE(PG8_SB(1, 0), cB + kstep, voffB); PG8_STAGE(PG8_SA(1, 0), cA + kstep, voffA); PG8_STAGE(PG8_SB(1, 1), cB + hB + kstep, voffB);
    PG8_WAIT_V(6); PG8_BAR;
    for (;;) {
        const bool has_next = S.next(ui + 1, nxt);
        const char* nA = has_next ? (const char*)g.A + (size_t)nxt.pm * tA + (size_t)nxt.pn * g.apn * 2 : cA; const char* nB = has_next ? (const char*)g.Bt + (size_t)nxt.pn * tB : cB;
        for (int t = 0; t < nt; t += 2) {
            const bool last = (t == nt - 2);
            const char* a1 = cA + (size_t)(t + 1) * kstep;
            const char* a2 = last ? nA : cA + (size_t)(t + 2) * kstep; const char* b2 = last ? nB : cB + (size_t)(t + 2) * kstep;
            const char* a3 = a2 + kstep; const char* b3 = b2 + kstep;
            PG8_LDB(B0, 0, 0); PG8_LDB(B1, 0, 1); PG8_SCHED; PG8_LDA(At, 0, 0); PG8_STAGE(PG8_SA(1, 1), a1 + hA, voffA);
            PG8_WAIT_V(8); PG8_WAIT_L(0); PG8_BAR; PG8_MMA(0, 0, At, B0); PG8_MMA(0, 1, At, B1); PG8_BAR; PG8_SCHED;
            PG8_LDA(At, 0, 1); PG8_STAGE(PG8_SB(0, 0), b2, voffB); PG8_STAGE(PG8_SB(0, 1), b2 + hB, voffB); PG8_STAGE(PG8_SA(0, 0), a2, voffA);
            PG8_WAIT_V(8); PG8_WAIT_L(0); PG8_BAR; PG8_MMA(1, 0, At, B0); PG8_MMA(1, 1, At, B1); PG8_BAR; PG8_SCHED;
            PG8_LDB(B0, 1, 0); PG8_LDB(B1, 1, 1); PG8_SCHED; PG8_LDA(At, 1, 0); PG8_STAGE(PG8_SA(0, 1), a2 + hA, voffA);
            PG8_WAIT_V(8); PG8_WAIT_L(0); PG8_BAR; PG8_MMA(0, 0, At, B0); PG8_MMA(0, 1, At, B1); PG8_BAR; PG8_SCHED;
            PG8_LDA(At, 1, 1); PG8_STAGE(PG8_SB(1, 0), b3, voffB); PG8_STAGE(PG8_SB(1, 1), b3 + hB, voffB); PG8_STAGE(PG8_SA(1, 0), a3, voffA);
            PG8_WAIT_V(8); PG8_WAIT_L(0); PG8_BAR; PG8_MMA(1, 0, At, B0); PG8_MMA(1, 1, At, B1); PG8_BAR; PG8_SCHED;
        }
        if constexpr (ALIGN_EPI) { if (wr == 0) PG8_BAR; }
        { int t2 = tid; asm volatile("" : "+v"(t2)); const int l2 = t2 & 63, w2 = __builtin_amdgcn_readfirstlane(t2 >> 6); E(acc, cur, w2 >> 2, w2 & 3, l2 & 15, l2 >> 4); }
        if (!has_next) break;
#pragma unroll
        for (int a = 0; a < 2; ++a)
#pragma unroll
            for (int b = 0; b < 2; ++b)
#pragma unroll
                for (int m = 0; m < 4; ++m)
#pragma unroll
                    for (int n = 0; n < 2; ++n) acc[a][b][m][n] = (f32x4){0.f, 0.f, 0.f, 0.f};
        cur = nxt; cA = nA; cB = nB; ++ui;
        if constexpr (ALIGN_EPI) { if (wr == 1) PG8_BAR; }
    }
    PG8_WAIT_V(0);
    if constexpr (!ALIGN_EPI) { if (wr == 0) PG8_BAR; }
    PG8_BAR;
#undef PG8_SA
#undef PG8_SB
#undef PG8_STAGE
#undef PG8_LDA
#undef PG8_LDB
#undef PG8_MMA
#undef PG8_WAIT_V
#undef PG8_WAIT_L
#undef PG8_BAR
#undef PG8_SCHED
}
}

constexpr size_t MiB = 1u << 20;
constexpr size_t WS_BAR  = 0;
constexpr size_t WS_WQKV = 2 * MiB;
constexpr size_t WS_WO   = WS_WQKV + 18 * MiB;
constexpr size_t WS_BIN  = WS_WO + 2 * MiB;
constexpr size_t WS_BGRP = WS_BIN + 2 * MiB;
constexpr size_t WS_BOUT = WS_BGRP + MiB / 2;
constexpr size_t WS_CIN  = WS_BOUT + 2 * MiB;
constexpr size_t WS_COUT = WS_CIN + 4 * MiB;
constexpr size_t WS_WGU  = WS_COUT + 2 * MiB;
constexpr size_t WS_WDN  = WS_WGU + 44 * MiB;
constexpr size_t WS_WPG  = WS_WDN + 22 * MiB;
constexpr size_t WS_WPP  = WS_WPG + 8 * MiB;
constexpr size_t WS_X0   = WS_WPP + 2 * MiB;
constexpr size_t WS_PBF  = WS_X0 + 64 * MiB;
constexpr size_t WS_LSE  = WS_PBF + 16 * MiB;
constexpr size_t WS_BIG  = WS_LSE + 3 * MiB;
constexpr size_t WS_X1   = WS_BIG + 224 * MiB;
constexpr size_t WS_SSQ  = WS_BIG + 288 * MiB;
constexpr size_t WS_END  = WS_SSQ + 4 * MiB;
static_assert(WS_END <= 512 * MiB, "workspace map");

constexpr int LDS_BYTES = 147456;

__constant__ unsigned char c_bucket[3][132] = {
 {0,1,2,3,4,5,6,7,8,9,10,11,12,13,14,15,16,16,16,16,16,16,17,17,17,17,17,17,17,17,18,18,18,18,18,18,18,18,18,18,19,19,19,19,19,19,19,19,19,19,19,19,19,19,20,20,20,20,20,20,20,20,20,20,20,20,20,20,20,20,20,20,20,21,21,21,21,21,21,21,21,21,21,21,21,21,21,21,21,21,21,21,21,21,21,21,21,21,21,22,22,22,22,22,22,22,22,22,22,22,22,22,22,22,22,22,22,22,22,22,22,22,22,22,22,22,22,22,22,0,0,0},
 {0,4,8,12,16,16,17,17,18,18,19,19,19,19,20,20,20,20,20,21,21,21,21,21,21,22,22,22,22,22,22,22,22,22,23,23,23,23,23,23,23,23,23,23,23,23,24,24,24,24,24,24,24,24,24,24,24,24,24,24,24,24,25,25,25,25,25,25,25,25,25,25,25,25,25,25,25,25,25,25,25,25,25,26,26,26,26,26,26,26,26,26,26,26,26,26,26,26,26,26,26,26,26,26,26,26,26,26,26,26,26,26,26,27,27,27,27,27,27,27,27,27,27,27,27,27,27,27,27,0,0,0},
 {0,16,18,19,20,21,21,22,22,23,23,23,24,24,24,24,25,25,25,25,25,26,26,26,26,26,26,26,26,27,27,27,27,27,27,27,27,27,27,28,28,28,28,28,28,28,28,28,28,28,28,28,29,29,29,29,29,29,29,29,29,29,29,29,29,29,29,29,29,29,30,30,30,30,30,30,30,30,30,30,30,30,30,30,30,30,30,30,30,30,30,30,30,30,30,31,31,31,31,31,31,31,31,31,31,31,31,31,31,31,31,31,31,31,31,31,31,31,31,31,31,31,31,31,31,31,31,31,31,0,0,0}};

enum { PT_PRO = 0, PT_QKV, PT_ATTN, PT_COMB, PT_WO, PT_BIN, PT_POOL, PT_BGRP, PT_BOUT, PT_CIN, PT_SGU, PT_COUT, PT_GU, PT_DOWN, PT_PGATE, PT_FINAL };
constexpr int NPHASE = 29;
__constant__ unsigned char c_prog[NPHASE][2] = {
    {PT_PRO, 0},
    {PT_QKV, 0}, {PT_ATTN, 0}, {PT_COMB, 0}, {PT_WO, 0}, {PT_GU, 0}, {PT_DOWN, 0}, {PT_PGATE, 0},
    {PT_BIN, 1}, {PT_POOL, 1}, {PT_BGRP, 1}, {PT_BOUT, 1}, {PT_GU, 1}, {PT_DOWN, 1}, {PT_PGATE, 1},
    {PT_CIN, 2}, {PT_SGU, 2}, {PT_COUT, 2}, {PT_GU, 2}, {PT_DOWN, 2}, {PT_PGATE, 2},
    {PT_QKV, 3}, {PT_ATTN, 3}, {PT_COMB, 3}, {PT_WO, 3}, {PT_GU, 3}, {PT_DOWN, 3}, {PT_PGATE, 3},
    {PT_FINAL, 0}};
__constant__ unsigned char c_hb_in[4] = {0, 1, 0, 0}, c_hb_mid[4] = {0, 1, 1, 0};

struct Args {
    const float* in[23];
    float* out; unsigned char* ws;
    int ph_lo, ph_hi;
};
enum { I_X = 0, I_P, I_REL, I_NMIX, I_NFFN, I_NPLE, I_FNORM, I_AQKV, I_AO, I_BIN, I_BGRP, I_BSCALE, I_BOUT, I_CIN, I_CVG, I_CWS, I_CBS, I_COUT, I_FG, I_FU, I_FD, I_PG, I_PP };

template <bool KS> __device__ __forceinline__ void transpose_item(const float* W, int K, int N, bf16_t* WT, int row_off, int mode, const float* kscale, LAS float* scr, int item, int lane) {
    const int nblk = N / 32, kb = item / nblk, nb = item % nblk, k0 = 64 * kb, n0 = 32 * nb;
    f32x4 v[8]; float ks[8];
#pragma unroll
    for (int j = 0; j < 8; ++j) { const int kk = 8 * j + (lane >> 3); v[j] = *(const f32x4*)(W + (size_t)(k0 + kk) * N + n0 + 4 * (lane & 7)); ks[j] = KS ? kscale[k0 + kk] : 1.0f; }
#pragma unroll
    for (int j = 0; j < 8; ++j) { const int kk = 8 * j + (lane >> 3); LAS float* d = scr + kk * 33 + 4 * (lane & 7); d[0] = v[j].x * ks[j]; d[1] = v[j].y * ks[j]; d[2] = v[j].z * ks[j]; d[3] = v[j].w * ks[j]; }
    asm volatile("s_waitcnt lgkmcnt(0)" ::: "memory");
    const int c = lane & 7;
    int drow0 = row_off + n0;
    if (mode) drow0 = (n0 >> 7) * 256 + (n0 & 127) + (mode == 2 ? 128 : 0);
#pragma unroll
    for (int j = 0; j < 4; ++j) { const int n = (lane >> 3) + 8 * j; const LAS float* s = scr + (8 * c) * 33 + n;
        u32x4 o; o.x = cvt_pk_bf16(s[0 * 33], s[1 * 33]); o.y = cvt_pk_bf16(s[2 * 33], s[3 * 33]); o.z = cvt_pk_bf16(s[4 * 33], s[5 * 33]); o.w = cvt_pk_bf16(s[6 * 33], s[7 * 33]);
        *(u32x4*)(WT + (size_t)(drow0 + n) * K + k0 + 8 * c) = o; }
    asm volatile("s_waitcnt lgkmcnt(0)" ::: "memory");
}
struct XposeCtx { LAS float* scr; int gw, NGW, lane; unsigned base; };
template <bool KS> __device__ __forceinline__ void transpose_matrix(XposeCtx& X, const float* W, int K, int N, bf16_t* WT, int row_off, int mode, const float* kscale) {
    const int nitems = (K / 64) * (N / 32);
    const int it0 = (int)(((unsigned)X.gw + (unsigned)X.NGW - X.base % (unsigned)X.NGW) % (unsigned)X.NGW);
    for (int it = it0; it < nitems; it += X.NGW) transpose_item<KS>(W, K, N, WT, row_off, mode, kscale, X.scr, it, X.lane);
    X.base += (unsigned)nitems;
}

__device__ __forceinline__ void rmsnorm_rows(const float* h, const float* g, bf16_t* outb, float* outf, int gw, int NGW, int lane) {
    f32x4 gv[4];
#pragma unroll
    for (int j = 0; j < 4; ++j) gv[j] = ((const f32x4*)g)[64 * j + lane];
    for (int m = gw; m < M; m += NGW) {
        const f32x4* xr = (const f32x4*)(h + (size_t)m * D) + lane;
        f32x4 v[4]; float s = 0.f;
#pragma unroll
        for (int j = 0; j < 4; ++j) { v[j] = xr[64 * j]; s += (v[j].x * v[j].x + v[j].y * v[j].y) + (v[j].z * v[j].z + v[j].w * v[j].w); }
        const float rstd = 1.0f / sqrtf(wave_sum(s) * (1.0f / D) + EPS);
        if (outb) { u32x2* o8 = (u32x2*)(outb + (size_t)m * D) + lane;
#pragma unroll
            for (int j = 0; j < 4; ++j) { u32x2 w; w.x = cvt_pk_bf16(v[j].x * rstd * gv[j].x, v[j].y * rstd * gv[j].y); w.y = cvt_pk_bf16(v[j].z * rstd * gv[j].z, v[j].w * rstd * gv[j].w); o8[64 * j] = w; } }
        else { f32x4* o = (f32x4*)(outf + (size_t)m * D) + lane;
#pragma unroll
            for (int j = 0; j < 4; ++j) o[64 * j] = v[j] * rstd * gv[j]; }
    }
}
__device__ __forceinline__ void final_rows(const bf16_t* hb, const float* g, float* outf, int gw, int NGW, int lane) {
    f32x4 gv[4];
#pragma unroll
    for (int j = 0; j < 4; ++j) gv[j] = ((const f32x4*)g)[64 * j + lane];
    for (int m0 = gw; m0 < M; m0 += 4 * NGW) {
        u32x2 w[4][4];
#pragma unroll
        for (int r = 0; r < 4; ++r) { const int m = m0 + r * NGW < M ? m0 + r * NGW : M - 1; const u32x2* xr = (const u32x2*)(hb + (size_t)m * D) + lane;
#pragma unroll
            for (int j = 0; j < 4; ++j) w[r][j] = xr[64 * j]; }
#pragma unroll
        for (int r = 0; r < 4; ++r) { const int m = m0 + r * NGW; f32x4 v[4]; float s = 0.f;
#pragma unroll
            for (int j = 0; j < 4; ++j) { v[j] = (f32x4){bf_lo(w[r][j].x), bf_hi(w[r][j].x), bf_lo(w[r][j].y), bf_hi(w[r][j].y)}; s += (v[j].x * v[j].x + v[j].y * v[j].y) + (v[j].z * v[j].z + v[j].w * v[j].w); }
            const float rstd = 1.0f / sqrtf(wave_sum(s) * (1.0f / D) + EPS);
            if (m < M) { f32x4* o = (f32x4*)(outf + (size_t)m * D) + lane;
#pragma unroll
                for (int j = 0; j < 4; ++j) o[64 * j] = v[j] * rstd * gv[j]; } }
    }
}
__device__ __forceinline__ void convert_p(const float* p, bf16_t* pb, int gtid, int NT) {
    const size_t n8 = (size_t)M * PLE / 8;
    for (size_t i0 = gtid; i0 < n8; i0 += (size_t)4 * NT) {
        f32x4 a[4], b[4];
#pragma unroll
        for (int r = 0; r < 4; ++r) { const size_t i = i0 + (size_t)r * NT < n8 ? i0 + (size_t)r * NT : n8 - 1; a[r] = ((const f32x4*)p)[2 * i]; b[r] = ((const f32x4*)p)[2 * i + 1]; }
#pragma unroll
        for (int r = 0; r < 4; ++r) { const size_t i = i0 + (size_t)r * NT; if (i < n8) { u32x4 w; w.x = cvt_pk_bf16(a[r].x, a[r].y); w.y = cvt_pk_bf16(a[r].z, a[r].w); w.z = cvt_pk_bf16(b[r].x, b[r].y); w.w = cvt_pk_bf16(b[r].z, b[r].w); ((u32x4*)pb)[i] = w; } }
    }
}

constexpr int ATT_K = 0, ATT_V = 49152, ATT_LUT = 98304;
__device__ __forceinline__ int kswz(int row) { return (((row >> 1) & 3) << 1) | ((row >> 3) & 1); }
struct AttnGeom { int g, h, d, qt, N0, qcol; size_t tok0; };
__device__ __forceinline__ AttnGeom attn_geom(int unit) {
    AttnGeom a; const int idx = unit & 1023, rest = idx >> 3, b = rest >> 5, wq = rest & 31;
    a.g = unit >> 10; a.h = idx & 7; const int sh = 2 * a.g, tpp = 32 >> sh; a.d = 1 << sh;
    const int r = wq / tpp; a.qt = wq % tpp; a.N0 = a.qt * 256; a.tok0 = (size_t)b * SEQ + r; a.qcol = a.g * 512 + a.h * 64; return a;
}
__device__ __forceinline__ void attn_fetch(const bf16_t* QKV, const AttnGeom& a, int tid, u32x4 (&kr)[6], u32x4 (&vr)[6], bf16x8 (&qf)[2][2]) {
    const int lane = tid & 63, w = tid >> 6, fr = lane & 15, G = lane >> 4;
#pragma unroll
    for (int i = 0; i < 6; ++i) { const int ix = tid + 512 * i, row = ix >> 3, ch = ix & 7; int step = a.N0 - 128 + row; step = step < 0 ? 0 : step;
        const bf16_t* rp = QKV + (a.tok0 + (size_t)step * a.d) * NQKV + a.qcol + ch * 8; kr[i] = *(const u32x4*)(rp + 1536); vr[i] = *(const u32x4*)(rp + 3072); }
#pragma unroll
    for (int qi = 0; qi < 2; ++qi) { const bf16_t* qp = QKV + (a.tok0 + (size_t)(a.N0 + 32 * w + 16 * qi + fr) * a.d) * NQKV + a.qcol + 8 * G;
        qf[qi][0] = *(const bf16x8*)qp; qf[qi][1] = *(const bf16x8*)(qp + 32); }
}
__device__ __forceinline__ void attn_phase(bf16_t* QKV, float* LSE, const float* rel_table, LAS unsigned char* lds, int bx, int Gd, int tid) {
    const int lane = tid & 63, w = __builtin_amdgcn_readfirstlane(tid >> 6), fr = lane & 15, G = lane >> 4;
    {   int bk[9]; float tv[9];
#pragma unroll
        for (int k = 0; k < 9; ++k) { const int e = tid + 512 * k, gh = e / 192, rel = e - gh * 192 - 31; const int rc = rel < 0 ? 0 : (rel > 128 ? 128 : rel); bk[k] = (int)c_bucket[gh >> 3][rc] * 24 + gh; }
#pragma unroll
        for (int k = 0; k < 9; ++k) tv[k] = rel_table[bk[k]];
#pragma unroll
        for (int k = 0; k < 9; ++k) { const int e = tid + 512 * k, gh = e / 192, rel = e - gh * 192 - 31; ((LAS float*)(lds + ATT_LUT))[e] = (rel >= 0 && rel <= 128) ? tv[k] * LOG2E : -1e30f; }
    }
    u32x4 kr[6], vr[6]; bf16x8 qn[2][2];
    int unit = bx; AttnGeom a = attn_geom(unit);
    if (unit < 3072) attn_fetch(QKV, a, tid, kr, vr, qn);
    const float c1 = 0.125f * LOG2E;
    const int q4 = fr >> 2, p4 = fr & 3;
    for (; unit < 3072; unit += Gd) {
#pragma unroll
        for (int i = 0; i < 6; ++i) { const int ix = tid + 512 * i, row = ix >> 3, ch = ix & 7; const bool neg = (a.N0 - 128 + row) < 0;
            const u32x4 z = (u32x4){0u, 0u, 0u, 0u};
            *(LAS u32x4*)(lds + ATT_K + row * 128 + ((ch ^ kswz(row)) * 16)) = neg ? z : kr[i];
            *(LAS u32x4*)(lds + ATT_V + row * 128 + ((((ch >> 1) ^ ((row >> 1) & 3)) * 32) + (ch & 1) * 16)) = neg ? z : vr[i]; }
        bf16x8 qf[2][2];
#pragma unroll
        for (int qi = 0; qi < 2; ++qi) { qf[qi][0] = qn[qi][0]; qf[qi][1] = qn[qi][1]; }
        const AttnGeom c = a;
        lds_barrier();
        { const int nu = unit + Gd; if (nu < 3072) { a = attn_geom(nu); attn_fetch(QKV, a, tid, kr, vr, qn); } }
        f32x4 O[2][4]; float mrun[2], lsum[2];
#pragma unroll
        for (int qi = 0; qi < 2; ++qi) { mrun[qi] = -1e29f; lsum[qi] = 0.f;
#pragma unroll
            for (int cc = 0; cc < 4; ++cc) O[qi][cc] = (f32x4){0.f, 0.f, 0.f, 0.f}; }
        const LAS float* lut = (const LAS float*)(lds + ATT_LUT) + (c.g * 8 + c.h) * 192;
#pragma unroll 1
        for (int c5 = 0; c5 < 5; ++c5) {
            const int kbase = 32 * w + 32 * c5;
            bf16x8 kf[2][2];
#pragma unroll
            for (int kt = 0; kt < 2; ++kt) { const int row = kbase + 16 * kt + fr;
#pragma unroll
                for (int s2 = 0; s2 < 2; ++s2) kf[kt][s2] = *(const LAS bf16x8*)(lds + ATT_K + row * 128 + (((G + 4 * s2) ^ kswz(row)) * 16)); }
            bf16x8 vf[4];
#pragma unroll
            for (int cc = 0; cc < 4; ++cc) {
                const int r0 = kbase + 4 * G + q4, r1 = r0 + 16;
                const s16x4 lo = __builtin_bit_cast(s16x4, __builtin_amdgcn_ds_read_tr16_b64_v4i16((LAS s16x4*)(lds + ATT_V + r0 * 128 + ((cc ^ ((r0 >> 1) & 3)) * 32) + 8 * p4)));
                const s16x4 hi = __builtin_bit_cast(s16x4, __builtin_amdgcn_ds_read_tr16_b64_v4i16((LAS s16x4*)(lds + ATT_V + r1 * 128 + ((cc ^ ((r1 >> 1) & 3)) * 32) + 8 * p4)));
                vf[cc] = (bf16x8){lo[0], lo[1], lo[2], lo[3], hi[0], hi[1], hi[2], hi[3]}; }
            const bool edge = (c.qt == 0) && (kbase < 128);
#pragma unroll
            for (int qi = 0; qi < 2; ++qi) {
                f32x4 S[2];
#pragma unroll
                for (int kt = 0; kt < 2; ++kt) { S[kt] = __builtin_amdgcn_mfma_f32_16x16x32_bf16(kf[kt][0], qf[qi][0], (f32x4){0.f, 0.f, 0.f, 0.f}, 0, 0, 0);
                    S[kt] = __builtin_amdgcn_mfma_f32_16x16x32_bf16(kf[kt][1], qf[qi][1], S[kt], 0, 0, 0); }
                float mx = -1e30f;
#pragma unroll
                for (int kt = 0; kt < 2; ++kt)
#pragma unroll
                    for (int i = 0; i < 4; ++i) { const int li = 159 + 16 * qi + fr - 4 * G - 32 * c5 - 16 * kt - i;
                        float sv = S[kt][i] * c1 + lut[li];
                        if (edge && (kbase + 16 * kt + 4 * G + i) < 128) sv = -1e30f;
                        S[kt][i] = sv; mx = fmaxf(mx, sv); }
                mx = fmaxf(mx, __shfl_xor(mx, 16)); mx = fmaxf(mx, __shfl_xor(mx, 32));
                const float mnew = fmaxf(mrun[qi], mx), alpha = fast_exp2(mrun[qi] - mnew); mrun[qi] = mnew;
                float ps = 0.f;
#pragma unroll
                for (int kt = 0; kt < 2; ++kt)
#pragma unroll
                    for (int i = 0; i < 4; ++i) { const float p = fast_exp2(S[kt][i] - mnew); S[kt][i] = p; ps += p; }
                lsum[qi] = lsum[qi] * alpha + ps;
                u32x4 pw; pw.x = cvt_pk_bf16(S[0][0], S[0][1]); pw.y = cvt_pk_bf16(S[0][2], S[0][3]); pw.z = cvt_pk_bf16(S[1][0], S[1][1]); pw.w = cvt_pk_bf16(S[1][2], S[1][3]);
                const bf16x8 pf = __builtin_bit_cast(bf16x8, pw);
#pragma unroll
                for (int cc = 0; cc < 4; ++cc) { O[qi][cc] = O[qi][cc] * alpha; O[qi][cc] = __builtin_amdgcn_mfma_f32_16x16x32_bf16(vf[cc], pf, O[qi][cc], 0, 0, 0); }
            }
        }
#pragma unroll
        for (int qi = 0; qi < 2; ++qi) {
            float l = lsum[qi]; l += __shfl_xor(l, 16); l += __shfl_xor(l, 32);
            const float inv = 1.0f / l;
            const size_t tok = c.tok0 + (size_t)(c.N0 + 32 * w + 16 * qi + fr) * c.d;
            bf16_t* op = QKV + tok * NQKV + c.qcol + 4 * G;
#pragma unroll
            for (int cc = 0; cc < 4; ++cc) { u32x2 o; o.x = cvt_pk_bf16(O[qi][cc][0] * inv, O[qi][cc][1] * inv); o.y = cvt_pk_bf16(O[qi][cc][2] * inv, O[qi][cc][3] * inv); *(u32x2*)(op + 16 * cc) = o; }
            if (G == 0) LSE[(tok * 3 + c.g) * 8 + c.h] = mrun[qi] + __log2f(l);
        }
        lds_barrier();
    }
}
__device__ __forceinline__ void attn_combine(bf16_t* QKV, const float* LSE, int gtid, int NT) {
    for (int ix0 = gtid; ix0 < M * 64; ix0 += 4 * NT) {
        float l[4][3]; u32x4 a[4][3];
#pragma unroll
        for (int r = 0; r < 4; ++r) { const int ix = ix0 + r * NT < M * 64 ? ix0 + r * NT : M * 64 - 1; const int tok = ix >> 6, h = (ix >> 3) & 7, ch = ix & 7;
            const bf16_t* qp = QKV + (size_t)tok * NQKV + h * 64 + ch * 8;
#pragma unroll
            for (int g = 0; g < 3; ++g) { l[r][g] = LSE[((size_t)tok * 3 + g) * 8 + h]; a[r][g] = *(const u32x4*)(qp + 512 * g); } }
#pragma unroll
        for (int r = 0; r < 4; ++r) { const int ix = ix0 + r * NT; const int tok = ix >> 6, h = (ix >> 3) & 7, ch = ix & 7;
            const float mx = fmaxf(l[r][0], fmaxf(l[r][1], l[r][2])); float w0 = fast_exp2(l[r][0] - mx), w1 = fast_exp2(l[r][1] - mx), w2 = fast_exp2(l[r][2] - mx); const float inv = 1.0f / (w0 + w1 + w2); w0 *= inv; w1 *= inv; w2 *= inv;
            u32x4 o;
#pragma unroll
            for (int j = 0; j < 4; ++j) { const float lo = w0 * bf_lo(a[r][0][j]) + w1 * bf_lo(a[r][1][j]) + w2 * bf_lo(a[r][2][j]), hi = w0 * bf_hi(a[r][0][j]) + w1 * bf_hi(a[r][1][j]) + w2 * bf_hi(a[r][2][j]); o[j] = cvt_pk_bf16(lo, hi); }
            if (ix < M * 64) *(u32x4*)(QKV + (size_t)tok * NQKV + 1536 + h * 64 + ch * 8) = o; }
    }
}

template <int WIN> __device__ __forceinline__ void pool_strip(const bf16_t* Y, bf16_t* Z, int t0, int col) {
    const int spos0 = t0 & (SEQ - 1);
    u32x4 r[WIN + 7];
#pragma unroll
    for (int i = 0; i < WIN + 7; ++i) { const int rel = i - (WIN - 1); const bool ok = spos0 + rel >= 0; const int tok = ok ? t0 + rel : t0;
        r[i] = *(const u32x4*)(Y + (size_t)tok * D + col); if (!ok) r[i] = (u32x4){0u, 0u, 0u, 0u}; }
    float S[8];
#pragma unroll
    for (int c = 0; c < 8; ++c) S[c] = 0.f;
#pragma unroll
    for (int i = 0; i < WIN - 1; ++i)
#pragma unroll
        for (int c = 0; c < 4; ++c) { S[2 * c] += bf_lo(r[i][c]); S[2 * c + 1] += bf_hi(r[i][c]); }
#pragma unroll
    for (int j = 0; j < 8; ++j) { const u32x4 y = r[WIN - 1 + j];
#pragma unroll
        for (int c = 0; c < 4; ++c) { S[2 * c] += bf_lo(y[c]); S[2 * c + 1] += bf_hi(y[c]); }
        const int n = (spos0 + j + 1) < WIN ? (spos0 + j + 1) : WIN; const float inv = 1.0f / (float)n; u32x4 o;
#pragma unroll
        for (int c = 0; c < 4; ++c) o[c] = cvt_pk_bf16(S[2 * c] * inv - bf_lo(y[c]), S[2 * c + 1] * inv - bf_hi(y[c]));
        *(u32x4*)(Z + (size_t)(t0 + j) * D + col) = o;
        const u32x4 q = r[j];
#pragma unroll
        for (int c = 0; c < 4; ++c) { S[2 * c] -= bf_lo(q[c]); S[2 * c + 1] -= bf_hi(q[c]); } }
}
__device__ __forceinline__ void pool_phase(const bf16_t* Y, bf16_t* Z, int gw, int NGW, int lane) {
    for (int it = gw; it < (M / 16) * 4; it += NGW) { const int g = it & 3, sp = it >> 2; const int t0 = (sp * 2 + (lane >> 5)) * 8, col = g * 256 + (lane & 31) * 8;
        if (g == 0) pool_strip<2>(Y, Z, t0, col); else if (g == 1) pool_strip<4>(Y, Z, t0, col); else if (g == 2) pool_strip<8>(Y, Z, t0, col); else pool_strip<16>(Y, Z, t0, col); }
}

constexpr int SG_VN = 0, SG_WM = 65536, SG_ST = 98304;
__device__ __forceinline__ void sgu_unit(const bf16_t* Zc, bf16_t* Gt, const float* vgain, const float* w_s, const float* b_s, LAS unsigned char* lds, int chunk, int tid) {
    const int lane = tid & 63, w = __builtin_amdgcn_readfirstlane(tid >> 6), fr = lane & 15, G = lane >> 4;
    const size_t t0 = (size_t)chunk * 128;
    LAS float* st = (LAS float*)(lds + SG_ST);
    for (int i0 = 0; i0 < 16; i0 += 4) {
        u32x4 a[4], b2[4];
#pragma unroll
        for (int r = 0; r < 4; ++r) { const u32x4* vp = (const u32x4*)(Zc + (t0 + 16 * w + i0 + r) * 2048 + 1024) + lane; a[r] = vp[0]; b2[r] = vp[64]; }
#pragma unroll
        for (int r = 0; r < 4; ++r) { const int t = 16 * w + i0 + r; float x[16];
#pragma unroll
            for (int j = 0; j < 4; ++j) { x[2 * j] = bf_lo(a[r][j]); x[2 * j + 1] = bf_hi(a[r][j]); x[8 + 2 * j] = bf_lo(b2[r][j]); x[9 + 2 * j] = bf_hi(b2[r][j]); }
            float sm = 0.f;
#pragma unroll
            for (int j = 0; j < 16; ++j) sm += x[j];
            const float mu = wave_sum(sm) * (1.0f / 1024.0f); float q = 0.f;
#pragma unroll
            for (int j = 0; j < 16; ++j) { const float dd = x[j] - mu; q += dd * dd; }
            const float rstd = 1.0f / sqrtf(wave_sum(q) * (1.0f / 1024.0f) + EPS);
            if (lane == 0) { st[2 * t] = mu; st[2 * t + 1] = rstd; } }
    }
    lds_barrier();
    for (int g = 0; g < 4; ++g) {
#pragma unroll
        for (int i = 0; i < 8; ++i) { const int ix = tid + 512 * i, s = ix >> 5, ch = ix & 31, c0 = g * 256 + ch * 8;
            const u32x4 a = *(const u32x4*)(Zc + (t0 + s) * 2048 + 1024 + c0); const f32x4 g0 = *(const f32x4*)(vgain + c0), g1 = *(const f32x4*)(vgain + c0 + 4);
            const float mu = st[2 * s], rs = st[2 * s + 1]; u32x4 o;
            o.x = cvt_pk_bf16((bf_lo(a.x) - mu) * rs * g0.x, (bf_hi(a.x) - mu) * rs * g0.y); o.y = cvt_pk_bf16((bf_lo(a.y) - mu) * rs * g0.z, (bf_hi(a.y) - mu) * rs * g0.w);
            o.z = cvt_pk_bf16((bf_lo(a.z) - mu) * rs * g1.x, (bf_hi(a.z) - mu) * rs * g1.y); o.w = cvt_pk_bf16((bf_lo(a.w) - mu) * rs * g1.z, (bf_hi(a.w) - mu) * rs * g1.w);
            const int sw = (s & 3) | (((s >> 3) & 1) << 2);
            *(LAS u32x4*)(lds + SG_VN + s * 512 + ((((ch >> 1) ^ sw)) * 32) + (ch & 1) * 16) = o; }
#pragma unroll
        for (int i = 0; i < 4; ++i) { const int ix = tid + 512 * i, t = ix >> 4, ch = ix & 15, s0 = ch * 8;
            const float* wp = w_s + ((size_t)g * 128 + t) * 128 + s0; const f32x4 a = *(const f32x4*)wp, b2 = *(const f32x4*)(wp + 4); float x[8] = {a.x, a.y, a.z, a.w, b2.x, b2.y, b2.z, b2.w};
#pragma unroll
            for (int j = 0; j < 8; ++j) if (s0 + j > t) x[j] = 0.f;
            u32x4 o; o.x = cvt_pk_bf16(x[0], x[1]); o.y = cvt_pk_bf16(x[2], x[3]); o.z = cvt_pk_bf16(x[4], x[5]); o.w = cvt_pk_bf16(x[6], x[7]);
            *(LAS u32x4*)(lds + SG_WM + t * 256 + ((ch ^ (t & 15)) * 16)) = o; }
        lds_barrier();
        f32x4 acc[2][8];
#pragma unroll
        for (int ct = 0; ct < 2; ++ct)
#pragma unroll
            for (int tt = 0; tt < 8; ++tt) acc[ct][tt] = (f32x4){0.f, 0.f, 0.f, 0.f};
        const int q4 = fr >> 2, p4 = fr & 3;
#pragma unroll
        for (int sc = 0; sc < 4; ++sc) {
            bf16x8 af[2];
#pragma unroll
            for (int ct = 0; ct < 2; ++ct) { const int r0 = 32 * sc + 8 * G + q4, r1 = r0 + 4, u32 = 2 * w + ct;
                const int sw0 = (r0 & 3) | (((r0 >> 3) & 1) << 2), sw1 = (r1 & 3) | (((r1 >> 3) & 1) << 2);
                const s16x4 lo = __builtin_bit_cast(s16x4, __builtin_amdgcn_ds_read_tr16_b64_v4i16((LAS s16x4*)(lds + SG_VN + r0 * 512 + ((u32 ^ sw0) * 32) + 8 * p4)));
                const s16x4 hi = __builtin_bit_cast(s16x4, __builtin_amdgcn_ds_read_tr16_b64_v4i16((LAS s16x4*)(lds + SG_VN + r1 * 512 + ((u32 ^ sw1) * 32) + 8 * p4)));
                af[ct] = (bf16x8){lo[0], lo[1], lo[2], lo[3], hi[0], hi[1], hi[2], hi[3]}; }
#pragma unroll
            for (int tt = 0; tt < 8; ++tt) { const int t = 16 * tt + fr; const bf16x8 bfr = *(const LAS bf16x8*)(lds + SG_WM + t * 256 + (((4 * sc + G) ^ (t & 15)) * 16));
#pragma unroll
                for (int ct = 0; ct < 2; ++ct) acc[ct][tt] = __builtin_amdgcn_mfma_f32_16x16x32_bf16(af[ct], bfr, acc[ct][tt], 0, 0, 0); }
        }
#pragma unroll
        for (int tt = 0; tt < 8; ++tt) { const int t = 16 * tt + fr; const float bs = b_s[g * 128 + t];
#pragma unroll
            for (int ct = 0; ct < 2; ++ct) { const int c = g * 256 + 32 * w + 16 * ct + 4 * G; const u32x2 uu = *(const u32x2*)(Zc + (t0 + t) * 2048 + c);
                u32x2 o; o.x = cvt_pk_bf16(bf_lo(uu.x) * (acc[ct][tt][0] + bs), bf_hi(uu.x) * (acc[ct][tt][1] + bs)); o.y = cvt_pk_bf16(bf_lo(uu.y) * (acc[ct][tt][2] + bs), bf_hi(uu.y) * (acc[ct][tt][3] + bs));
                *(u32x2*)(Gt + (t0 + t) * 1024 + c) = o; } }
        lds_barrier();
    }
}

#define XB_TMO      128
#define XB_XCNT(j)  (256  + 64 * (j))
#define XB_XSUB(j)  (1280 + 64 * (j))
#define XB_XGEN(j)  (2304 + 64 * (j))
#define XB_TOP      3328
#define XB_TOPGEN   3392
#define XCD_BAR_WORDS 3456
#define XB_SPIN_CAP (1u << 18)

__device__ __forceinline__ unsigned xb_ld(unsigned* p)              { return __hip_atomic_load(p, __ATOMIC_RELAXED, __HIP_MEMORY_SCOPE_AGENT); }
__device__ __forceinline__ unsigned xb_add(unsigned* p, unsigned v) { return __hip_atomic_fetch_add(p, v, __ATOMIC_RELAXED, __HIP_MEMORY_SCOPE_AGENT); }
__device__ __forceinline__ unsigned xb_xcc_id() { return (unsigned)__builtin_amdgcn_s_getreg((3 << 11) | 20) & 0xFu; }
#define XB_SPIN(cond, bar) do { unsigned _sp = 0; while (cond) { __builtin_amdgcn_s_sleep(1); \
    if ((++_sp & 255u) == 0u) { if (xb_ld(&(bar)[XB_TMO])) break; if (_sp > XB_SPIN_CAP) { atomicAdd(&(bar)[XB_TMO], 1u); break; } } } } while (0)

struct XcdBarrier {
    unsigned* bar; unsigned x;
    volatile LAS unsigned* st;
};

__device__ __forceinline__ XcdBarrier xcd_barrier_post(unsigned* bar, volatile LAS unsigned* st) {
    XcdBarrier b; b.bar = bar; b.x = xb_xcc_id(); b.st = st;
    if (threadIdx.x == 0) st[2] = xb_add(&bar[XB_XCNT(b.x)], 1u);
    return b;
}
__device__ __forceinline__ void xcd_barrier_complete(unsigned* bar, unsigned x, unsigned& nloc, unsigned& nx) {
    const unsigned G = gridDim.x * gridDim.y * gridDim.z;
    unsigned sum, cnt, mine, sp = 0u;
    for (;;) {
        sum = 0u; cnt = 0u; mine = 0u;
#pragma unroll
        for (unsigned j = 0; j < 16; ++j) { const unsigned c = xb_ld(&bar[XB_XCNT(j)]); sum += c; cnt += (c > 0u) ? 1u : 0u; mine = (j == x) ? c : mine; }
        if (sum == G) break;
        __builtin_amdgcn_s_sleep(1);
        if ((++sp & 255u) == 0u) { if (xb_ld(&bar[XB_TMO])) break; if (sp > XB_SPIN_CAP) { atomicAdd(&bar[XB_TMO], 1u); break; } }
    }
    nloc = mine > 0u ? mine : 1u; nx = cnt > 0u ? cnt : 1u;
}
__device__ __forceinline__ unsigned xcd_census_uniform(unsigned* bar, unsigned nloc) {
    unsigned ok = 1u;
#pragma unroll
    for (unsigned j = 0; j < 16; ++j) { const unsigned c = xb_ld(&bar[XB_XCNT(j)]); if (c != (j < 8u ? nloc : 0u)) ok = 0u; }
    return ok;
}
#define XB_LSUB(j)  (4096 + 64 * (j))
#define XB_LGEN(j)  (5120 + 64 * (j))
#define XB_ALL_WORDS 6144
__device__ __forceinline__ void xcd_local_barrier(const XcdBarrier& b) {
    asm volatile("s_waitcnt vmcnt(0)" ::: "memory");
    __syncthreads();
    if (threadIdx.x == 0) {
        unsigned* bar = b.bar; const unsigned nloc = b.st[0];
        const unsigned old = xb_add(&bar[XB_LSUB(b.x)], 1u), gen = old / nloc;
        if (old + 1u == (gen + 1u) * nloc) xb_add(&bar[XB_LGEN(b.x)], 1u);
        else XB_SPIN(xb_ld(&bar[XB_LGEN(b.x)]) == gen, bar);
        __builtin_amdgcn_fence(__ATOMIC_ACQUIRE, "agent");
        asm volatile("s_waitcnt vmcnt(0)" ::: "memory");
    }
    __syncthreads();
}

__device__ __forceinline__ void xcd_barrier(const XcdBarrier& b) {
    asm volatile("s_waitcnt vmcnt(0)" ::: "memory");
    __syncthreads();
    if (threadIdx.x == 0) {
        unsigned* bar = b.bar;
        __builtin_amdgcn_s_waitcnt(0);
        unsigned nloc = b.st[0], nx = b.st[1];
        if (nloc == 0u) { xcd_barrier_complete(bar, b.x, nloc, nx); b.st[0] = nloc; b.st[1] = nx; b.st[3] = xcd_census_uniform(bar, nloc); }
        const unsigned old = xb_add(&bar[XB_XSUB(b.x)], 1u);
        const unsigned gen = old / nloc;
        if (old + 1u == (gen + 1u) * nloc) {
            __builtin_amdgcn_fence(__ATOMIC_RELEASE, "agent");
            asm volatile("s_waitcnt vmcnt(0)" ::: "memory");
            const unsigned og = xb_add(&bar[XB_TOP], 1u);
            const unsigned tg = og / nx;
            if (og + 1u == (tg + 1u) * nx) xb_add(&bar[XB_TOPGEN], 1u);
            else XB_SPIN(xb_ld(&bar[XB_TOPGEN]) == tg, bar);
            __builtin_amdgcn_fence(__ATOMIC_ACQUIRE, "agent");
            xb_add(&bar[XB_XGEN(b.x)], 1u);
            asm volatile("s_waitcnt vmcnt(0)" ::: "memory");
        } else {
            XB_SPIN(xb_ld(&bar[XB_XGEN(b.x)]) == gen, bar);
            __builtin_amdgcn_fence(__ATOMIC_ACQUIRE, "agent");
            asm volatile("s_waitcnt vmcnt(0)" ::: "memory");
        }
    }
    __syncthreads();
}

__device__ __forceinline__ void x_rows(const float* x, bf16_t* xb, pg8::ssq_t* ssq, int gw, int NGW, int lane) {
    for (int m0 = gw; m0 < M; m0 += 4 * NGW) {
        f32x4 v[4][4];
#pragma unroll
        for (int r = 0; r < 4; ++r) { const int m = m0 + r * NGW < M ? m0 + r * NGW : M - 1; const f32x4* xr = (const f32x4*)(x + (size_t)m * D) + lane;
#pragma unroll
            for (int j = 0; j < 4; ++j) v[r][j] = xr[64 * j]; }
#pragma unroll
        for (int r = 0; r < 4; ++r) { const int m = m0 + r * NGW; float s = 0.f;
#pragma unroll
            for (int j = 0; j < 4; ++j) s += (v[r][j].x * v[r][j].x + v[r][j].y * v[r][j].y) + (v[r][j].z * v[r][j].z + v[r][j].w * v[r][j].w);
            s = wave_sum(s);
            if (m < M) { u32x2* o8 = (u32x2*)(xb + (size_t)m * D) + lane;
#pragma unroll
                for (int j = 0; j < 4; ++j) { u32x2 w; w.x = cvt_pk_bf16(v[r][j].x, v[r][j].y); w.y = cvt_pk_bf16(v[r][j].z, v[r][j].w); o8[64 * j] = w; }
                if (lane == 0) ssq[m] = (pg8::ssq_t)(s * pg8::SSQ_SCALE); } }
    }
}

__global__ void __launch_bounds__(512, 2) fwd_kernel(Args args) {
    extern __shared__ __attribute__((aligned(16))) unsigned char lds_raw[];
    LAS unsigned char* lds = (LAS unsigned char*)lds_raw;
    if (threadIdx.x < 16) ((LAS unsigned*)(lds + 131072))[threadIdx.x] = 0u;
    __syncthreads();
    XcdBarrier xbar; xbar.bar = (unsigned*)(args.ws + WS_BAR); xbar.x = 0; xbar.st = (volatile LAS unsigned*)(lds + 131072);
    for (int ph = args.ph_lo; ph < args.ph_hi; ++ph) {
        const __attribute__((address_space(4))) Args* ap = (const __attribute__((address_space(4))) Args*)__builtin_amdgcn_kernarg_segment_ptr(); asm volatile("" : "+s"(ap));
        int tid = threadIdx.x; asm volatile("" : "+v"(tid));
        const int lane = tid & 63, wave = __builtin_amdgcn_readfirstlane(tid >> 6);
        int Gd = gridDim.x, bx = blockIdx.x; asm volatile("" : "+s"(Gd), "+s"(bx));
        const int gw = bx * 8 + wave, NGW = Gd * 8, gtid = bx * 512 + tid, NT = Gd * 512;
        unsigned char* ws = ap->ws; asm volatile("" : "+s"(ws)); ws = as_global(ws);
        bf16_t* PBF = (bf16_t*)(ws + WS_PBF); float* LSE = (float*)(ws + WS_LSE); bf16_t* BIG = (bf16_t*)(ws + WS_BIG);
        pg8::ssq_t* SSQ = (pg8::ssq_t*)(ws + WS_SSQ);
        float* H = as_global(ap->out);
        const int type = c_prog[ph][0], layer = c_prog[ph][1];
        bf16_t* HBin = (bf16_t*)(ws + (c_hb_in[layer] ? WS_X1 : WS_X0)); bf16_t* HBmid = (bf16_t*)(ws + (c_hb_mid[layer] ? WS_X1 : WS_X0)); bf16_t* HBoth = (bf16_t*)(ws + (c_hb_mid[layer] ? WS_X0 : WS_X1));
        pg8::Gemm gm{nullptr, nullptr, M, 0, 0, 0, 0, 0}; int epi = -1; bf16_t* ob = nullptr; int ldc = 0; const pg8::ssq_t* ssq_in = SSQ + (size_t)13 * M; pg8::ssq_t* ssq_out = nullptr; bf16_t* hbo = nullptr; const bf16_t* hbase = nullptr;
        bool second = false; bool conv_p = false;
        switch (type) {
#ifndef DIS_PRO
        case PT_PRO: {
            if (bx == 0 && ph == 0) for (int i = tid; i < XB_ALL_WORDS; i += 512) ((unsigned*)(ws + WS_BAR))[i] = 0u;
            unsigned cz = 0u, co = 1073740750u; asm volatile("" : "+v"(cz), "+v"(co));
            for (int i = gtid; i < 12 * M / 2; i += NT) ((u32x4*)(SSQ + M))[i] = (u32x4){cz, cz, cz, cz};
            for (int i = gtid; i < M / 2; i += NT) ((u32x4*)(SSQ + (size_t)13 * M))[i] = (u32x4){co, cz, co, cz};
            XposeCtx X{(LAS float*)(lds + wave * 16384), gw, NGW, lane, 0u};
            for (int j = 0; j < 2; ++j) {
                transpose_matrix<true>(X, as_global(ap->in[I_AQKV]) + (size_t)j * D * NQKV, D, NQKV, (bf16_t*)(ws + WS_WQKV) + (size_t)j * NQKV * D, 0, 0, as_global(ap->in[I_NMIX]) + (j ? 3 : 0) * D);
                transpose_matrix<false>(X, as_global(ap->in[I_AO]) + (size_t)j * 512 * D, 512, D, (bf16_t*)(ws + WS_WO) + (size_t)j * D * 512, 0, 0, nullptr);
            }
            transpose_matrix<true>(X, as_global(ap->in[I_BIN]), D, D, (bf16_t*)(ws + WS_BIN), 0, 0, as_global(ap->in[I_NMIX]) + 1 * D);
            for (int g = 0; g < 4; ++g) transpose_matrix<false>(X, as_global(ap->in[I_BGRP]) + (size_t)g * 65536, 256, 256, (bf16_t*)(ws + WS_BGRP), g * 256, 0, nullptr);
            transpose_matrix<true>(X, as_global(ap->in[I_BOUT]), D, D, (bf16_t*)(ws + WS_BOUT), 0, 0, as_global(ap->in[I_BSCALE]));
            transpose_matrix<true>(X, as_global(ap->in[I_CIN]), D, 2048, (bf16_t*)(ws + WS_CIN), 0, 0, as_global(ap->in[I_NMIX]) + 2 * D);
            transpose_matrix<false>(X, as_global(ap->in[I_COUT]), D, D, (bf16_t*)(ws + WS_COUT), 0, 0, nullptr);
            for (int i = 0; i < DEPTH; ++i) {
                transpose_matrix<true>(X, as_global(ap->in[I_FG]) + (size_t)i * D * FF, D, FF, (bf16_t*)(ws + WS_WGU) + (size_t)i * 2 * FF * D, 0, 1, as_global(ap->in[I_NFFN]) + i * D);
                transpose_matrix<true>(X, as_global(ap->in[I_FU]) + (size_t)i * D * FF, D, FF, (bf16_t*)(ws + WS_WGU) + (size_t)i * 2 * FF * D, 0, 2, as_global(ap->in[I_NFFN]) + i * D);
                transpose_matrix<false>(X, as_global(ap->in[I_FD]) + (size_t)i * FF * D, FF, D, (bf16_t*)(ws + WS_WDN) + (size_t)i * D * FF, 0, 0, nullptr);
                transpose_matrix<true>(X, as_global(ap->in[I_PG]) + (size_t)i * D * D, D, D, (bf16_t*)(ws + WS_WPG) + (size_t)i * D * D, 0, 0, as_global(ap->in[I_NPLE]) + i * D);
                transpose_matrix<false>(X, as_global(ap->in[I_PP]) + (size_t)i * PLE * D, PLE, D, (bf16_t*)(ws + WS_WPP) + (size_t)i * D * PLE, 0, 0, nullptr);
            }
            x_rows(as_global(ap->in[I_X]), (bf16_t*)(ws + WS_X0), SSQ, gw, NGW, lane);
            convert_p(as_global(ap->in[I_P]), PBF, gtid, NT);
        } break;
#endif
        case PT_FINAL: final_rows((const bf16_t*)(ws + WS_X1), as_global(ap->in[I_FNORM]), H, gw, NGW, lane); break;
        case PT_QKV: gm.A = HBin; gm.Bt = (bf16_t*)(ws + WS_WQKV) + (size_t)(layer / 3) * NQKV * D; gm.N = NQKV; gm.K = D; gm.lda = D; gm.ldb = D; epi = 0; ob = BIG; ldc = NQKV; ssq_in = SSQ + (size_t)(3 * layer) * M; conv_p = layer > 0; break;
#ifndef DIS_ATTN
        case PT_ATTN: attn_phase(BIG, LSE, as_global(ap->in[I_REL]), lds, bx, Gd, tid); break;
#endif
        case PT_COMB: attn_combine(BIG, LSE, gtid, NT); break;
        case PT_WO: gm.A = BIG + 1536; gm.Bt = (bf16_t*)(ws + WS_WO) + (size_t)(layer / 3) * D * 512; gm.N = D; gm.K = 512; gm.lda = NQKV; gm.ldb = 512; epi = 3; hbo = HBmid; ssq_out = SSQ + (size_t)(3 * layer + 1) * M; hbase = HBin; break;
        case PT_BIN: gm.A = HBin; gm.Bt = (bf16_t*)(ws + WS_BIN); gm.N = D; gm.K = D; gm.lda = D; gm.ldb = D; epi = 0; ob = BIG; ldc = D; ssq_in = SSQ + (size_t)(3 * layer) * M; conv_p = true; break;
        case PT_POOL: pool_phase(BIG, BIG + (size_t)M * D, gw, NGW, lane); break;
        case PT_BGRP: gm.A = BIG + (size_t)M * D; gm.Bt = (bf16_t*)(ws + WS_BGRP); gm.N = D; gm.K = 256; gm.lda = D; gm.ldb = 256; gm.apn = 256; epi = 0; ob = BIG + (size_t)2 * M * D; ldc = D; break;
        case PT_BOUT: gm.A = BIG + (size_t)2 * M * D; gm.Bt = (bf16_t*)(ws + WS_BOUT); gm.N = D; gm.K = D; gm.lda = D; gm.ldb = D; epi = 3; hbo = HBmid; ssq_out = SSQ + (size_t)(3 * layer + 1) * M; hbase = HBin; break;
        case PT_CIN: gm.A = HBin; gm.Bt = (bf16_t*)(ws + WS_CIN); gm.N = 2048; gm.K = D; gm.lda = D; gm.ldb = D; epi = 1; ob = BIG; ldc = 2048; ssq_in = SSQ + (size_t)(3 * layer) * M; conv_p = true; break;
#ifndef DIS_SGU
        case PT_SGU: for (int u = bx; u < M / 128; u += Gd) sgu_unit(BIG, BIG + (size_t)M * 2048, as_global(ap->in[I_CVG]), as_global(ap->in[I_CWS]), as_global(ap->in[I_CBS]), lds, u, tid); break;
#endif
        case PT_COUT: gm.A = BIG + (size_t)M * 2048; gm.Bt = (bf16_t*)(ws + WS_COUT); gm.N = D; gm.K = D; gm.lda = D; gm.ldb = D; epi = 3; hbo = HBmid; ssq_out = SSQ + (size_t)(3 * layer + 1) * M; hbase = HBin; break;
        case PT_GU: gm.A = HBmid; gm.Bt = (bf16_t*)(ws + WS_WGU) + (size_t)layer * 2 * FF * D; gm.N = 2 * FF; gm.K = D; gm.lda = D; gm.ldb = D; epi = 2; ob = BIG; ldc = FF; ssq_in = SSQ + (size_t)(3 * layer + 1) * M; break;
        case PT_DOWN: gm.A = BIG; gm.Bt = (bf16_t*)(ws + WS_WDN) + (size_t)layer * D * FF; gm.N = D; gm.K = FF; gm.lda = FF; gm.ldb = FF; epi = 3; hbo = HBmid; ssq_out = SSQ + (size_t)(3 * layer + 2) * M; second = true; hbase = HBmid; break;
        case PT_PGATE: gm.A = HBmid; gm.Bt = (bf16_t*)(ws + WS_WPG) + (size_t)layer * D * D; gm.N = D; gm.K = D; gm.lda = D; gm.ldb = D; epi = 4; ssq_in = SSQ + (size_t)(3 * layer + 2) * M; ssq_out = SSQ + (size_t)(3 * layer + 3) * M; break;
        default: break;
        }
#ifndef DIS_GEMM
        if (epi >= 0) {
            int cv = bx;
            { volatile LAS unsigned* st = (volatile LAS unsigned*)(lds + 131072); if (st[3] && Gd == 256) cv = (int)(st[2] * 8u + xbar.x); cv = __builtin_amdgcn_readfirstlane(cv); }
            pg8::StaticOrder S; S.init(M, gm.N, Gd, cv);
#ifdef ONLY_EPI
            if (epi != ONLY_EPI) epi = 99;
#endif
            if (epi == 99) {} else
            if (epi == 0) { pg8::EpiBf16<0> E{ob, ldc, ssq_in}; pg8::gemm_phase<pg8::EpiBf16<0>, true>(lds, gm, S, E, tid); }
            else if (epi == 1) { pg8::EpiBf16<1> E{ob, ldc, ssq_in}; pg8::gemm_phase<pg8::EpiBf16<1>, true>(lds, gm, S, E, tid); }
            else if (epi == 2) { pg8::EpiSwiGLU E{ob, ldc, ssq_in}; pg8::gemm_phase<pg8::EpiSwiGLU, true>(lds, gm, S, E, tid); }
            else if (epi == 3) { pg8::EpiRes E{hbase, hbo, ssq_out}; pg8::gemm_phase<pg8::EpiRes, false>(lds, gm, S, E, tid); }
            else { pg8::EpiPle E{HBmid, HBoth, ssq_in, ssq_out}; pg8::gemm_phase<pg8::EpiPle, false>(lds, gm, S, E, tid); }
        }
        if (second) {
            pg8::Gemm g2{PBF, (bf16_t*)(ws + WS_WPP) + (size_t)layer * D * PLE, M, D, PLE, PLE, PLE, 0};
            int cv = bx; { volatile LAS unsigned* st = (volatile LAS unsigned*)(lds + 131072); if (st[3] && Gd == 256) cv = (int)(st[2] * 8u + xbar.x); cv = __builtin_amdgcn_readfirstlane(cv); }
            pg8::StaticOrder S; S.init(M, D, Gd, cv);
            pg8::EpiBf16<0> E{HBoth, D, SSQ + (size_t)13 * M}; pg8::gemm_phase<pg8::EpiBf16<0>, true>(lds, g2, S, E, tid);
        }
#endif
        if (conv_p) convert_p(as_global(ap->in[I_P]) + (size_t)layer * M * PLE, PBF, gtid, NT);
        if (ph + 1 < args.ph_hi) {
            if (ph == 0) { cg::this_grid().sync(); xbar = xcd_barrier_post((unsigned*)(args.ws + WS_BAR), (volatile LAS unsigned*)(lds + 131072)); }
            else {
                const volatile LAS unsigned* st = (const volatile LAS unsigned*)(lds + 131072);
                const bool loc = (type == PT_GU || type == PT_DOWN) && st[3] != 0u && Gd == 256;
                if (loc) xcd_local_barrier(xbar); else xcd_barrier(xbar);
            }
        }
    }
}

extern "C" void kernel_launch(void* const* d_in, const int* in_sizes, int n_in, void* d_out, int out_size, void* d_ws, size_t ws_size, hipStream_t stream) {
    static int grid = 0;
    if (grid == 0) {
        if (n_in != 23 || out_size != M * D || ws_size < WS_END) { fprintf(stderr, "kernel_launch: unexpected problem (n_in %d, out %d, ws %zu < %zu)\n", n_in, out_size, ws_size, (size_t)WS_END); grid = -1; return; }
        int dev = 0, cus = 0, per_cu = 0;
        hipGetDevice(&dev); hipDeviceGetAttribute(&cus, hipDeviceAttributeMultiprocessorCount, dev);
        if (hipFuncSetAttribute((const void*)fwd_kernel, hipFuncAttributeMaxDynamicSharedMemorySize, LDS_BYTES) != hipSuccess) { fprintf(stderr, "kernel_launch: hipFuncSetAttribute failed\n"); grid = -1; return; }
        if (hipOccupancyMaxActiveBlocksPerMultiprocessor(&per_cu, (const void*)fwd_kernel, 512, LDS_BYTES) != hipSuccess || per_cu < 1) { fprintf(stderr, "kernel_launch: occupancy query says %d blocks/CU\n", per_cu); per_cu = 1; }
        (void)hipGetLastError();
        grid = cus;
    }
    if (grid < 0) return;
    Args a{};
    for (int i = 0; i < 23; ++i) a.in[i] = (const float*)d_in[i];
    a.out = (float*)d_out; a.ws = (unsigned char*)d_ws;
#if MK_PER_PHASE
    for (int ph = 0; ph < NPHASE; ++ph) { a.ph_lo = ph; a.ph_hi = ph + 1; hipLaunchKernelGGL(fwd_kernel, dim3(grid), dim3(512), LDS_BYTES, stream, a); }
#else
    a.ph_lo = 0; a.ph_hi = NPHASE;
    void* kargs[] = {&a};
    hipError_t e = hipLaunchCooperativeKernel((const void*)fwd_kernel, dim3(grid), dim3(512), kargs, LDS_BYTES, stream);
    if (e != hipSuccess) fprintf(stderr, "cooperative launch failed: %s (grid %d)\n", hipGetErrorString(e), grid);
#endif
}
```

```cpp
#include <hip/hip_runtime.h>
#include <hip/hip_cooperative_groups.h>
#include <cstdio>
#include <cstdint>
namespace cg = cooperative_groups;

#ifndef MK_PER_PHASE
#define MK_PER_PHASE 0
#endif

#define LAS __attribute__((address_space(3)))
typedef unsigned short bf16_t;
typedef short bf16x8 __attribute__((ext_vector_type(8)));
typedef short s16x4 __attribute__((ext_vector_type(4)));
typedef float f32x4 __attribute__((ext_vector_type(4)));
typedef float f32x2 __attribute__((ext_vector_type(2)));
typedef unsigned u32x4 __attribute__((ext_vector_type(4)));
typedef unsigned u32x2 __attribute__((ext_vector_type(2)));

constexpr int D = 1024, BATCH = 4, SEQ = 8192, M = BATCH * SEQ, DEPTH = 4;
constexpr int NQKV = 4608, FF = 2816, PLE = 256;
constexpr float EPS = 1e-6f;
constexpr float LOG2E = 1.4426950408889634f;

__device__ __forceinline__ unsigned cvt_pk_bf16(float lo, float hi) { unsigned r; asm volatile("v_cvt_pk_bf16_f32 %0, %1, %2" : "=v"(r) : "v"(lo), "v"(hi)); return r; }
__device__ __forceinline__ float bf_lo(unsigned u) { return __uint_as_float(u << 16); }
__device__ __forceinline__ float bf_hi(unsigned u) { return __uint_as_float(u & 0xffff0000u); }
__device__ __forceinline__ float fast_exp2(float x) { return __builtin_amdgcn_exp2f(x); }
__device__ __forceinline__ float fast_rcp(float x) { return __builtin_amdgcn_rcpf(x); }
__device__ __forceinline__ float sigmoidf_(float x) { return fast_rcp(1.0f + fast_exp2(-LOG2E * x)); }
__device__ __forceinline__ float siluf_(float x) { return x * sigmoidf_(x); }
__device__ __forceinline__ float gelu_tanh(float x) { const float u = 0.7978845608028654f * (x + 0.044715f * x * x * x); return x * fast_rcp(1.0f + fast_exp2(-2.0f * LOG2E * u)); }
__device__ __forceinline__ void lds_barrier() { asm volatile("s_waitcnt lgkmcnt(0)\n\ts_barrier" ::: "memory"); }
__device__ __forceinline__ float wave_sum(float v) {
#pragma unroll
    for (int o = 1; o < 64; o <<= 1) v += __shfl_xor(v, o);
    return v;
}

template <class T> __device__ __forceinline__ T* as_global(T* p) { __attribute__((address_space(1))) T* g = (__attribute__((address_space(1))) T*)p; asm volatile("" : "+s"(g)); return (T*)g; }

namespace pg8 {
constexpr int BM = 256, BK = 64, HALF = 128, HTB = HALF * BK * 2, STAGE_BYTES = 8 * HTB, NXCD = 8, WGM = 8;
__host__ __device__ __forceinline__ int lds_byte(int r, int c) { const int st = (r >> 4) * 2 + (c >> 5), rr = r & 15, cc = c & 31, ob = rr * 64 + cc * 2; return st * 1024 + (ob ^ (((ob >> 9) & 1) << 5)); }
__host__ __device__ __forceinline__ void stage_rc(int b, int& R, int& C) { const int st = b / 1024, sb = b % 1024, swz = sb ^ (((sb >> 9) & 1) << 5); R = (st >> 1) * 16 + swz / 64; C = (st & 1) * 32 + (swz % 64) / 2; }
__host__ __device__ __forceinline__ int perm32(int rho) { const int n = rho >> 4, i = rho & 15; return 8 * (i >> 2) + 4 * n + (i & 3); }

struct Unit { int pm, pn; };
struct Gemm { const bf16_t* A; const bf16_t* Bt; int M, N, K, lda, ldb, apn; };

struct StaticOrder {
    int nM, nN, nwg, G, c;
    __device__ void init(int M_, int N_, int G_, int c_) { nM = M_ / BM; nN = N_ / BM; nwg = nM * nN; G = G_; c = c_; }
    __device__ bool next(int i, Unit& u) const {
        const long L = (long)i * G + c; if (L >= nwg) return false;
        int wgid = (int)L; { const int q = nwg / NXCD, r = nwg % NXCD, xcd = wgid % NXCD, off = wgid / NXCD; wgid = (xcd < r ? xcd * (q + 1) : r * (q + 1) + (xcd - r) * q) + off; }
        const int nig = WGM * nN, gid = wgid / nig, fm = gid * WGM, gsz = (nM - fm) < WGM ? (nM - fm) : WGM;
        u.pm = fm + ((wgid % nig) % gsz); u.pn = (wgid % nig) / gsz; return true;
    }
};

typedef unsigned long long ssq_t;
constexpr float SSQ_SCALE = 1048576.0f, SSQ_INV = 1.0f / 1048576.0f;
__device__ __forceinline__ void load_rstd(float (&rsv)[2][4], const ssq_t* ssq, int row0) {
    ssq_t t[2][4];
#pragma unroll
    for (int ai = 0; ai < 2; ++ai)
#pragma unroll
        for (int m = 0; m < 4; ++m) t[ai][m] = ssq[row0 + ai * HALF + m * 16];
#pragma unroll
    for (int ai = 0; ai < 2; ++ai)
#pragma unroll
        for (int m = 0; m < 4; ++m) rsv[ai][m] = __builtin_amdgcn_rsqf((float)t[ai][m] * (SSQ_INV / 1024.0f) + 1e-6f);
}
__device__ __forceinline__ void ssq_add(ssq_t* p, float v) { __hip_atomic_fetch_add((__attribute__((address_space(1))) ssq_t*)p, (ssq_t)(v * SSQ_SCALE), __ATOMIC_RELAXED, __HIP_MEMORY_SCOPE_AGENT); }
template <int ACT> struct EpiBf16 {
    static constexpr bool PERM = true;
    bf16_t* O; int ldc; const ssq_t* ssq;
    __device__ __forceinline__ void operator()(const f32x4 (&acc)[2][2][4][2], const Unit& u, int wr, int wc, int fr, int fq) const {
        const int row0 = u.pm * BM + wr * 64 + fr, col0 = u.pn * BM + wc * 32 + 8 * fq;
        float rsv[2][4]; load_rstd(rsv, ssq, row0);
#pragma unroll
        for (int ai = 0; ai < 2; ++ai)
#pragma unroll
            for (int m = 0; m < 4; ++m) { const int row = row0 + ai * HALF + m * 16; bf16_t* rowp = O + (size_t)row * ldc + col0; const float rs = rsv[ai][m];
#pragma unroll
                for (int bj = 0; bj < 2; ++bj) { f32x4 v0 = acc[ai][bj][m][0] * rs, v1 = acc[ai][bj][m][1] * rs;
                    if (ACT == 1) {
#pragma unroll
                        for (int j = 0; j < 4; ++j) { v0[j] = gelu_tanh(v0[j]); v1[j] = gelu_tanh(v1[j]); } }
                    u32x4 w; w.x = cvt_pk_bf16(v0[0], v0[1]); w.y = cvt_pk_bf16(v0[2], v0[3]); w.z = cvt_pk_bf16(v1[0], v1[1]); w.w = cvt_pk_bf16(v1[2], v1[3]);
                    *(u32x4*)(rowp + bj * HALF) = w; } }
    }
};
struct EpiSwiGLU {
    static constexpr bool PERM = true;
    bf16_t* O; int ldc; const ssq_t* ssq;
    __device__ __forceinline__ void operator()(const f32x4 (&acc)[2][2][4][2], const Unit& u, int wr, int wc, int fr, int fq) const {
        const int row0 = u.pm * BM + wr * 64 + fr, col0 = u.pn * HALF + wc * 32 + 8 * fq;
        float rsv[2][4]; load_rstd(rsv, ssq, row0);
#pragma unroll
        for (int ai = 0; ai < 2; ++ai)
#pragma unroll
            for (int m = 0; m < 4; ++m) { const int row = row0 + ai * HALF + m * 16; bf16_t* rowp = O + (size_t)row * ldc + col0; const float rs = rsv[ai][m];
                f32x4 v0, v1;
#pragma unroll
                for (int j = 0; j < 4; ++j) { v0[j] = siluf_(acc[ai][0][m][0][j] * rs) * (acc[ai][1][m][0][j] * rs); v1[j] = siluf_(acc[ai][0][m][1][j] * rs) * (acc[ai][1][m][1][j] * rs); }
                u32x4 w; w.x = cvt_pk_bf16(v0[0], v0[1]); w.y = cvt_pk_bf16(v0[2], v0[3]); w.z = cvt_pk_bf16(v1[0], v1[1]); w.w = cvt_pk_bf16(v1[2], v1[3]);
                *(u32x4*)rowp = w; }
    }
};
#define ER_OFF(q, bj) (off0 + (unsigned)((((q) >> 2) * HALF + ((q) & 3) * 16) * 1024 + (bj) * HALF))
#define ER_STORE(q) do { float sq = 0.f; \
            _Pragma("unroll") for (int bj = 0; bj < 2; ++bj) { const unsigned o = ER_OFF(q, bj); const f32x4 r0 = acc[(q) >> 2][bj][(q) & 3][0], r1 = acc[(q) >> 2][bj][(q) & 3][1]; \
                u32x4 w; w.x = cvt_pk_bf16(r0[0], r0[1]); w.y = cvt_pk_bf16(r0[2], r0[3]); w.z = cvt_pk_bf16(r1[0], r1[1]); w.w = cvt_pk_bf16(r1[2], r1[3]); \
                *(u32x4*)(hb + o) = w; \
                _Pragma("unroll") for (int j = 0; j < 4; ++j) { const float a = bf_lo(w[j]), b = bf_hi(w[j]); sq += a * a + b * b; } } \
            sq += __shfl_xor(sq, 16); sq += __shfl_xor(sq, 32); \
            if (fq == 0) ssq_add(ssq_out + row0 + ((q) >> 2) * HALF + ((q) & 3) * 16, sq); } while (0)
struct EpiRes {
    static constexpr bool PERM = true;
    const bf16_t* base; bf16_t* hb; ssq_t* ssq_out;
    __device__ __forceinline__ void operator()(f32x4 (&acc)[2][2][4][2], const Unit& u, int wr, int wc, int fr, int fq) const {
        const int row0 = u.pm * BM + wr * 64 + fr, col0 = u.pn * BM + wc * 32 + 8 * fq; const unsigned off0 = (unsigned)row0 * 1024u + (unsigned)col0;
        u32x4 t[4][2];
#define ER_LOAD(q) do { _Pragma("unroll") for (int bj = 0; bj < 2; ++bj) t[(q) & 3][bj] = *(const u32x4*)(base + ER_OFF(q, bj)); } while (0)
#define ER_ADD(q) do { _Pragma("unroll") for (int bj = 0; bj < 2; ++bj) { f32x4& a0 = acc[(q) >> 2][bj][(q) & 3][0]; f32x4& a1 = acc[(q) >> 2][bj][(q) & 3][1]; const u32x4 p = t[(q) & 3][bj]; \
            a0[0] += bf_lo(p.x); a0[1] += bf_hi(p.x); a0[2] += bf_lo(p.y); a0[3] += bf_hi(p.y); a1[0] += bf_lo(p.z); a1[1] += bf_hi(p.z); a1[2] += bf_lo(p.w); a1[3] += bf_hi(p.w); } } while (0)
#pragma unroll
        for (int q = 0; q < 4; ++q) ER_LOAD(q);
#pragma unroll
        for (int q = 0; q < 4; ++q) ER_ADD(q);
#pragma unroll
        for (int q = 4; q < 8; ++q) ER_LOAD(q);
#pragma unroll
        for (int q = 0; q < 4; ++q) ER_STORE(q);
#pragma unroll
        for (int q = 4; q < 8; ++q) { ER_ADD(q); ER_STORE(q); }
#undef ER_LOAD
#undef ER_ADD
    }
};
struct EpiPle {
    static constexpr bool PERM = true;
    const bf16_t* base; bf16_t* pp; const ssq_t* ssq; ssq_t* ssq_out;
    __device__ __forceinline__ void operator()(f32x4 (&acc)[2][2][4][2], const Unit& u, int wr, int wc, int fr, int fq) const {
        const int row0 = u.pm * BM + wr * 64 + fr, col0 = u.pn * BM + wc * 32 + 8 * fq; const unsigned off0 = (unsigned)row0 * 1024u + (unsigned)col0;
        float rsv[2][4]; load_rstd(rsv, ssq, row0);
        u32x4 t[2][2], pw[2][2];
#define EP_LOAD(q) do { _Pragma("unroll") for (int bj = 0; bj < 2; ++bj) { const unsigned o = ER_OFF(q, bj); t[(q) & 1][bj] = *(const u32x4*)(base + o); pw[(q) & 1][bj] = *(const u32x4*)(pp + o); } } while (0)
#define EP_ADD(q) do { _Pragma("unroll") for (int bj = 0; bj < 2; ++bj) { const float rs = rsv[(q) >> 2][(q) & 3]; const f32x4 a0 = acc[(q) >> 2][bj][(q) & 3][0] * rs, a1 = acc[(q) >> 2][bj][(q) & 3][1] * rs; const u32x4 p = pw[(q) & 1][bj], b = t[(q) & 1][bj]; f32x4 r0, r1; \
            r0[0] = bf_lo(b.x) + bf_lo(p.x) * sigmoidf_(a0[0]); r0[1] = bf_hi(b.x) + bf_hi(p.x) * sigmoidf_(a0[1]); r0[2] = bf_lo(b.y) + bf_lo(p.y) * sigmoidf_(a0[2]); r0[3] = bf_hi(b.y) + bf_hi(p.y) * sigmoidf_(a0[3]); \
            r1[0] = bf_lo(b.z) + bf_lo(p.z) * sigmoidf_(a1[0]); r1[1] = bf_hi(b.z) + bf_hi(p.z) * sigmoidf_(a1[1]); r1[2] = bf_lo(b.w) + bf_lo(p.w) * sigmoidf_(a1[2]); r1[3] = bf_hi(b.w) + bf_hi(p.w) * sigmoidf_(a1[3]); \
            acc[(q) >> 2][bj][(q) & 3][0] = r0; acc[(q) >> 2][bj][(q) & 3][1] = r1; } } while (0)
        bf16_t* hb = pp;
        EP_LOAD(0); EP_LOAD(1); EP_ADD(0); EP_ADD(1);
#pragma unroll
        for (int q = 0; q < 8; q += 2) { if (q < 6) { EP_LOAD(q + 2); EP_LOAD(q + 3); } ER_STORE(q); ER_STORE(q + 1); if (q < 6) { EP_ADD(q + 2); EP_ADD(q + 3); } }
#undef EP_LOAD
#undef EP_ADD
    }
};
#undef ER_STORE
#undef ER_OFF

template <class Epi, bool ALIGN_EPI>
__device__ __forceinline__ void gemm_phase(LAS unsigned char* lds, const Gemm g, const StaticOrder& S, const Epi& E, const int tid) {
    const int wid = __builtin_amdgcn_readfirstlane(tid >> 6), lane = tid & 63, wr = wid >> 2, wc = wid & 3, fr = lane & 15, fq = lane >> 4;
    const int K = g.K, nt = K / BK;
    unsigned voffA[2], voffB[2];
#pragma unroll
    for (int i = 0; i < 2; ++i) { int R, C; stage_rc(tid * 16 + i * 8192, R, C); const int Rb = Epi::PERM ? ((R & ~31) + perm32(R & 31)) : R;
        voffA[i] = (unsigned)(R * g.lda + C) * 2u; voffB[i] = (unsigned)(Rb * g.ldb + C) * 2u; }
    const size_t kstep = (size_t)(BK * 2);
    const size_t hA = (size_t)HALF * g.lda * 2, hB = (size_t)HALF * g.ldb * 2, tA = 2 * hA, tB = 2 * hB;
    const unsigned ldsw = (unsigned)wid * 1024u;
    const int aoff = lds_byte(wr * 64 + fr, fq * 8), boff = lds_byte(wc * 32 + fr, fq * 8);
#define PG8_SA(b, h) (((b) * 2 + (h)) * HTB)
#define PG8_SB(b, h) ((4 + (b) * 2 + (h)) * HTB)
#define PG8_STAGE(bufoff, gbase, voff) do { _Pragma("unroll") for (int _i = 0; _i < 2; ++_i) \
        __builtin_amdgcn_global_load_lds((const unsigned*)((const char*)(gbase) + (voff)[_i]), (LAS unsigned*)(lds + (bufoff) + ldsw + _i * 8192), 16, 0, 0); } while (0)
#define PG8_LDA(dst, b, h) do { _Pragma("unroll") for (int m = 0; m < 4; ++m) _Pragma("unroll") for (int k = 0; k < 2; ++k) dst[m][k] = *(const LAS bf16x8*)(lds + PG8_SA(b, h) + aoff + m * 2048 + k * 1024); } while (0)
#define PG8_LDB(dst, b, h) do { _Pragma("unroll") for (int n = 0; n < 2; ++n) _Pragma("unroll") for (int k = 0; k < 2; ++k) dst[n][k] = *(const LAS bf16x8*)(lds + PG8_SB(b, h) + boff + n * 2048 + k * 1024); } while (0)
#define PG8_MMA(ai, bj, At, Bt) do { __builtin_amdgcn_s_setprio(1); _Pragma("unroll") for (int k = 0; k < 2; ++k) _Pragma("unroll") for (int m = 0; m < 4; ++m) _Pragma("unroll") for (int n = 0; n < 2; ++n) \
        acc[ai][bj][m][n] = __builtin_amdgcn_mfma_f32_16x16x32_bf16(Bt[n][k], At[m][k], acc[ai][bj][m][n], 0, 0, 0); __builtin_amdgcn_s_setprio(0); } while (0)
#define PG8_WAIT_V(n) asm volatile("s_waitcnt vmcnt(" #n ")" ::: "memory")
#define PG8_WAIT_L(n) asm volatile("s_waitcnt lgkmcnt(" #n ")" ::: "memory")
#define PG8_BAR __builtin_amdgcn_s_barrier()
#define PG8_SCHED __builtin_amdgcn_sched_barrier(0)
    Unit cur, nxt; int ui = 0;
    if (!S.next(0, cur)) return;
    f32x4 acc[2][2][4][2];
#pragma unroll
    for (int a = 0; a < 2; ++a)
#pragma unroll
        for (int b = 0; b < 2; ++b)
#pragma unroll
            for (int m = 0; m < 4; ++m)
#pragma unroll
                for (int n = 0; n < 2; ++n) acc[a][b][m][n] = (f32x4){0.f, 0.f, 0.f, 0.f};
    bf16x8 At[4][2], B0[2][2], B1[2][2];
    const char* cA = (const char*)g.A + (size_t)cur.pm * tA + (size_t)cur.pn * g.apn * 2; const char* cB = (const char*)g.Bt + (size_t)cur.pn * tB;
    PG8_STAGE(PG8_SB(0, 0), cB, voffB); PG8_STAGE(PG8_SB(0, 1), cB + hB, voffB); PG8_STAGE(PG8_SA(0, 0), cA, voffA); PG8_STAGE(PG8_SA(0, 1), cA + hA, voffA);
    if (wr == 1) PG8_BAR;
    PG8_WAIT_V(2); PG8_BAR;
    PG8_STAGE(PG8_SB(1, 0), cB + kstep, voffB); PG8_STAGE(PG8_SA(1, 0), cA + kstep, voffA); PG8_STAGE(PG8_SB(1, 1), cB + hB + kstep, voffB);
    PG8_WAIT_V(6); PG8_BAR;
    for (;;) {
        const bool has_next = S.next(ui + 1, nxt);
        const char* nA = has_next ? (const char*)g.A + (size_t)nxt.pm * tA + (size_t)nxt.pn * g.apn * 2 : cA; const char* nB = has_next ? (const char*)g.Bt + (size_t)nxt.pn * tB : cB;
        for (int t = 0; t < nt; t += 2) {
            const bool last = (t == nt - 2);
            const char* a1 = cA + (size_t)(t + 1) * kstep;
            const char* a2 = last ? nA : cA + (size_t)(t + 2) * kstep; const char* b2 = last ? nB : cB + (size_t)(t + 2) * kstep;
            const char* a3 = a2 + kstep; const char* b3 = b2 + kstep;
            PG8_LDB(B0, 0, 0); PG8_LDB(B1, 0, 1); PG8_SCHED; PG8_LDA(At, 0, 0); PG8_STAGE(PG8_SA(1, 1), a1 + hA, voffA);
            PG8_WAIT_V(8); PG8_WAIT_L(0); PG8_BAR; PG8_MMA(0, 0, At, B0); PG8_MMA(0, 1, At, B1); PG8_BAR; PG8_SCHED;
            PG8_LDA(At, 0, 1); PG8_STAGE(PG8_SB(0, 0), b2, voffB); PG8_STAGE(PG8_SB(0, 1), b2 + hB, voffB); PG8_STAGE(PG8_SA(0, 0), a2, voffA);
            PG8_WAIT_V(8); PG8_WAIT_L(0); PG8_BAR; PG8_MMA(1, 0, At, B0); PG8_MMA(1, 1, At, B1); PG8_BAR; PG8_SCHED;
            PG8_LDB(B0, 1, 0); PG8_LDB(B1, 1, 1); PG8_SCHED; PG8_LDA(At, 1, 0); PG8_STAGE(PG8_SA(0, 1), a2 + hA, voffA);
            PG8_WAIT_V(8); PG8_WAIT_L(0); PG8_BAR; PG8_MMA(0, 0, At, B0); PG8_MMA(0, 1, At, B1); PG8_BAR; PG8_SCHED;
            PG8_LDA(At, 1, 1); PG8_STAGE(PG8_SB(1, 0), b3, voffB); PG8_STAGE(PG8_SB(1, 1), b3 + hB, voffB); PG8_STAGE(PG8_SA(1, 0), a3, voffA);
            PG8_WAIT_V(8); PG8_WAIT_L(0); PG8_BAR; PG8_MMA(1, 0, At, B0); PG8_MMA(1, 1, At, B1); PG8_BAR; PG8_SCHED;
        }
        if constexpr (ALIGN_EPI) { if (wr == 0) PG8_BAR; }
        { int t2 = tid; asm volatile("" : "+v"(t2)); const int l2 = t2 & 63, w2 = __builtin_amdgcn_readfirstlane(t2 >> 6); E(acc, cur, w2 >> 2, w2 & 3, l2 & 15, l2 >> 4); }
        if (!has_next) break;
#pragma unroll
        for (int a = 0; a < 2; ++a)
#pragma unroll
            for (int b = 0; b < 2; ++b)
#pragma unroll
                for (int m = 0; m < 4; ++m)
#pragma unroll
                    for (int n = 0; n < 2; ++n) acc[a][b][m][n] = (f32x4){0.f, 0.f, 0.f, 0.f};
        cur = nxt; cA = nA; cB = nB; ++ui;
        if constexpr (ALIGN_EPI) { if (wr == 1) PG8_BAR; }
    }
    PG8_WAIT_V(0);
    if constexpr (!ALIGN_EPI) { if (wr == 0) PG8_BAR; }
    PG8_BAR;
#undef PG8_SA
#undef PG8_SB
#undef PG8_STAGE
#undef PG8_LDA
#undef PG8_LDB
#undef PG8_MMA
#undef PG8_WAIT_V
#undef PG8_WAIT_L
#undef PG8_BAR
#undef PG8_SCHED
}
}

constexpr size_t MiB = 1u << 20;
constexpr size_t WS_BAR  = 0;
constexpr size_t WS_WQKV = 2 * MiB;
constexpr size_t WS_WO   = WS_WQKV + 18 * MiB;
constexpr size_t WS_BIN  = WS_WO + 2 * MiB;
constexpr size_t WS_BGRP = WS_BIN + 2 * MiB;
constexpr size_t WS_BOUT = WS_BGRP + MiB / 2;
constexpr size_t WS_CIN  = WS_BOUT + 2 * MiB;
constexpr size_t WS_COUT = WS_CIN + 4 * MiB;
constexpr size_t WS_WGU  = WS_COUT + 2 * MiB;
constexpr size_t WS_WDN  = WS_WGU + 44 * MiB;
constexpr size_t WS_WPG  = WS_WDN + 22 * MiB;
constexpr size_t WS_WPP  = WS_WPG + 8 * MiB;
constexpr size_t WS_X0   = WS_WPP + 2 * MiB;
constexpr size_t WS_PBF  = WS_X0 + 64 * MiB;
constexpr size_t WS_LSE  = WS_PBF + 16 * MiB;
constexpr size_t WS_BIG  = WS_LSE + 3 * MiB;
constexpr size_t WS_X1   = WS_BIG + 224 * MiB;
constexpr size_t WS_SSQ  = WS_BIG + 288 * MiB;
constexpr size_t WS_END  = WS_SSQ + 4 * MiB;
static_assert(WS_END <= 512 * MiB, "workspace map");

constexpr int LDS_BYTES = 147456;

__constant__ unsigned char c_bucket[3][132] = {
 {0,1,2,3,4,5,6,7,8,9,10,11,12,13,14,15,16,16,16,16,16,16,17,17,17,17,17,17,17,17,18,18,18,18,18,18,18,18,18,18,19,19,19,19,19,19,19,19,19,19,19,19,19,19,20,20,20,20,20,20,20,20,20,20,20,20,20,20,20,20,20,20,20,21,21,21,21,21,21,21,21,21,21,21,21,21,21,21,21,21,21,21,21,21,21,21,21,21,21,22,22,22,22,22,22,22,22,22,22,22,22,22,22,22,22,22,22,22,22,22,22,22,22,22,22,22,22,22,22,0,0,0},
 {0,4,8,12,16,16,17,17,18,18,19,19,19,19,20,20,20,20,20,21,21,21,21,21,21,22,22,22,22,22,22,22,22,22,23,23,23,23,23,23,23,23,23,23,23,23,24,24,24,24,24,24,24,24,24,24,24,24,24,24,24,24,25,25,25,25,25,25,25,25,25,25,25,25,25,25,25,25,25,25,25,25,25,26,26,26,26,26,26,26,26,26,26,26,26,26,26,26,26,26,26,26,26,26,26,26,26,26,26,26,26,26,26,27,27,27,27,27,27,27,27,27,27,27,27,27,27,27,27,0,0,0},
 {0,16,18,19,20,21,21,22,22,23,23,23,24,24,24,24,25,25,25,25,25,26,26,26,26,26,26,26,26,27,27,27,27,27,27,27,27,27,27,28,28,28,28,28,28,28,28,28,28,28,28,28,29,29,29,29,29,29,29,29,29,29,29,29,29,29,29,29,29,29,30,30,30,30,30,30,30,30,30,30,30,30,30,30,30,30,30,30,30,30,30,30,30,30,30,31,31,31,31,31,31,31,31,31,31,31,31,31,31,31,31,31,31,31,31,31,31,31,31,31,31,31,31,31,31,31,31,31,31,0,0,0}};

enum { PT_PRO = 0, PT_QKV, PT_ATTN, PT_COMB, PT_WO, PT_BIN, PT_POOL, PT_BGRP, PT_BOUT, PT_CIN, PT_SGU, PT_COUT, PT_GU, PT_DOWN, PT_PGATE, PT_FINAL };
constexpr int NPHASE = 29;
__constant__ unsigned char c_prog[NPHASE][2] = {
    {PT_PRO, 0},
    {PT_QKV, 0}, {PT_ATTN, 0}, {PT_COMB, 0}, {PT_WO, 0}, {PT_GU, 0}, {PT_DOWN, 0}, {PT_PGATE, 0},
    {PT_BIN, 1}, {PT_POOL, 1}, {PT_BGRP, 1}, {PT_BOUT, 1}, {PT_GU, 1}, {PT_DOWN, 1}, {PT_PGATE, 1},
    {PT_CIN, 2}, {PT_SGU, 2}, {PT_COUT, 2}, {PT_GU, 2}, {PT_DOWN, 2}, {PT_PGATE, 2},
    {PT_QKV, 3}, {PT_ATTN, 3}, {PT_COMB, 3}, {PT_WO, 3}, {PT_GU, 3}, {PT_DOWN, 3}, {PT_PGATE, 3},
    {PT_FINAL, 0}};
__constant__ unsigned char c_hb_in[4] = {0, 1, 0, 0}, c_hb_mid[4] = {0, 1, 1, 0};

struct Args {
    const float* in[23];
    float* out; unsigned char* ws;
    int ph_lo, ph_hi;
};
enum { I_X = 0, I_P, I_REL, I_NMIX, I_NFFN, I_NPLE, I_FNORM, I_AQKV, I_AO, I_BIN, I_BGRP, I_BSCALE, I_BOUT, I_CIN, I_CVG, I_CWS, I_CBS, I_COUT, I_FG, I_FU, I_FD, I_PG, I_PP };

template <bool KS> __device__ __forceinline__ void transpose_item(const float* W, int K, int N, bf16_t* WT, int row_off, int mode, const float* kscale, LAS float* scr, int item, int lane) {
    const int nblk = N / 32, kb = item / nblk, nb = item % nblk, k0 = 64 * kb, n0 = 32 * nb;
    f32x4 v[8]; float ks[8];
#pragma unroll
    for (int j = 0; j < 8; ++j) { const int kk = 8 * j + (lane >> 3); v[j] = *(const f32x4*)(W + (size_t)(k0 + kk) * N + n0 + 4 * (lane & 7)); ks[j] = KS ? kscale[k0 + kk] : 1.0f; }
#pragma unroll
    for (int j = 0; j < 8; ++j) { const int kk = 8 * j + (lane >> 3); LAS float* d = scr + kk * 33 + 4 * (lane & 7); d[0] = v[j].x * ks[j]; d[1] = v[j].y * ks[j]; d[2] = v[j].z * ks[j]; d[3] = v[j].w * ks[j]; }
    asm volatile("s_waitcnt lgkmcnt(0)" ::: "memory");
    const int c = lane & 7;
    int drow0 = row_off + n0;
    if (mode) drow0 = (n0 >> 7) * 256 + (n0 & 127) + (mode == 2 ? 128 : 0);
#pragma unroll
    for (int j = 0; j < 4; ++j) { const int n = (lane >> 3) + 8 * j; const LAS float* s = scr + (8 * c) * 33 + n;
        u32x4 o; o.x = cvt_pk_bf16(s[0 * 33], s[1 * 33]); o.y = cvt_pk_bf16(s[2 * 33], s[3 * 33]); o.z = cvt_pk_bf16(s[4 * 33], s[5 * 33]); o.w = cvt_pk_bf16(s[6 * 33], s[7 * 33]);
        *(u32x4*)(WT + (size_t)(drow0 + n) * K + k0 + 8 * c) = o; }
    asm volatile("s_waitcnt lgkmcnt(0)" ::: "memory");
}
struct XposeCtx { LAS float* scr; int gw, NGW, lane; unsigned base; };
template <bool KS> __device__ __forceinline__ void transpose_matrix(XposeCtx& X, const float* W, int K, int N, bf16_t* WT, int row_off, int mode, const float* kscale) {
    const int nitems = (K / 64) * (N / 32);
    const int it0 = (int)(((unsigned)X.gw + (unsigned)X.NGW - X.base % (unsigned)X.NGW) % (unsigned)X.NGW);
    for (int it = it0; it < nitems; it += X.NGW) transpose_item<KS>(W, K, N, WT, row_off, mode, kscale, X.scr, it, X.lane);
    X.base += (unsigned)nitems;
}

__device__ __forceinline__ void rmsnorm_rows(const float* h, const float* g, bf16_t* outb, float* outf, int gw, int NGW, int lane) {
    f32x4 gv[4];
#pragma unroll
    for (int j = 0; j < 4; ++j) gv[j] = ((const f32x4*)g)[64 * j + lane];
    for (int m = gw; m < M; m += NGW) {
        const f32x4* xr = (const f32x4*)(h + (size_t)m * D) + lane;
        f32x4 v[4]; float s = 0.f;
#pragma unroll
        for (int j = 0; j < 4; ++j) { v[j] = xr[64 * j]; s += (v[j].x * v[j].x + v[j].y * v[j].y) + (v[j].z * v[j].z + v[j].w * v[j].w); }
        const float rstd = 1.0f / sqrtf(wave_sum(s) * (1.0f / D) + EPS);
        if (outb) { u32x2* o8 = (u32x2*)(outb + (size_t)m * D) + lane;
#pragma unroll
            for (int j = 0; j < 4; ++j) { u32x2 w; w.x = cvt_pk_bf16(v[j].x * rstd * gv[j].x, v[j].y * rstd * gv[j].y); w.y = cvt_pk_bf16(v[j].z * rstd * gv[j].z, v[j].w * rstd * gv[j].w); o8[64 * j] = w; } }
        else { f32x4* o = (f32x4*)(outf + (size_t)m * D) + lane;
#pragma unroll
            for (int j = 0; j < 4; ++j) o[64 * j] = v[j] * rstd * gv[j]; }
    }
}
__device__ __forceinline__ void final_rows(const bf16_t* hb, const float* g, float* outf, int gw, int NGW, int lane) {
    f32x4 gv[4];
#pragma unroll
    for (int j = 0; j < 4; ++j) gv[j] = ((const f32x4*)g)[64 * j + lane];
    for (int m0 = gw; m0 < M; m0 += 4 * NGW) {
        u32x2 w[4][4];
#pragma unroll
        for (int r = 0; r < 4; ++r) { const int m = m0 + r * NGW < M ? m0 + r * NGW : M - 1; const u32x2* xr = (const u32x2*)(hb + (size_t)m * D) + lane;
#pragma unroll
            for (int j = 0; j < 4; ++j) w[r][j] = xr[64 * j]; }
#pragma unroll
        for (int r = 0; r < 4; ++r) { const int m = m0 + r * NGW; f32x4 v[4]; float s = 0.f;
#pragma unroll
            for (int j = 0; j < 4; ++j) { v[j] = (f32x4){bf_lo(w[r][j].x), bf_hi(w[r][j].x), bf_lo(w[r][j].y), bf_hi(w[r][j].y)}; s += (v[j].x * v[j].x + v[j].y * v[j].y) + (v[j].z * v[j].z + v[j].w * v[j].w); }
            const float rstd = 1.0f / sqrtf(wave_sum(s) * (1.0f / D) + EPS);
            if (m < M) { f32x4* o = (f32x4*)(outf + (size_t)m * D) + lane;
#pragma unroll
                for (int j = 0; j < 4; ++j) o[64 * j] = v[j] * rstd * gv[j]; } }
    }
}
__device__ __forceinline__ void convert_p(const float* p, bf16_t* pb, int gtid, int NT) {
    const size_t n8 = (size_t)M * PLE / 8;
    for (size_t i0 = gtid; i0 < n8; i0 += (size_t)4 * NT) {
        f32x4 a[4], b[4];
#pragma unroll
        for (int r = 0; r < 4; ++r) { const size_t i = i0 + (size_t)r * NT < n8 ? i0 + (size_t)r * NT : n8 - 1; a[r] = ((const f32x4*)p)[2 * i]; b[r] = ((const f32x4*)p)[2 * i + 1]; }
#pragma unroll
        for (int r = 0; r < 4; ++r) { const size_t i = i0 + (size_t)r * NT; if (i < n8) { u32x4 w; w.x = cvt_pk_bf16(a[r].x, a[r].y); w.y = cvt_pk_bf16(a[r].z, a[r].w); w.z = cvt_pk_bf16(b[r].x, b[r].y); w.w = cvt_pk_bf16(b[r].z, b[r].w); ((u32x4*)pb)[i] = w; } }
    }
}

constexpr int ATT_K = 0, ATT_V = 49152, ATT_LUT = 98304;
__device__ __forceinline__ int kswz(int row) { return (((row >> 1) & 3) << 1) | ((row >> 3) & 1); }
struct AttnGeom { int g, h, d, qt, N0, qcol; size_t tok0; };
__device__ __forceinline__ AttnGeom attn_geom(int unit) {
    AttnGeom a; const int idx = unit & 1023, rest = idx >> 3, b = rest >> 5, wq = rest & 31;
    a.g = unit >> 10; a.h = idx & 7; const int sh = 2 * a.g, tpp = 32 >> sh; a.d = 1 << sh;
    const int r = wq / tpp; a.qt = wq % tpp; a.N0 = a.qt * 256; a.tok0 = (size_t)b * SEQ + r; a.qcol = a.g * 512 + a.h * 64; return a;
}
__device__ __forceinline__ void attn_fetch(const bf16_t* QKV, const AttnGeom& a, int tid, u32x4 (&kr)[6], u32x4 (&vr)[6], bf16x8 (&qf)[2][2]) {
    const int lane = tid & 63, w = tid >> 6, fr = lane & 15, G = lane >> 4;
#pragma unroll
    for (int i = 0; i < 6; ++i) { const int ix = tid + 512 * i, row = ix >> 3, ch = ix & 7; int step = a.N0 - 128 + row; step = step < 0 ? 0 : step;
        const bf16_t* rp = QKV + (a.tok0 + (size_t)step * a.d) * NQKV + a.qcol + ch * 8; kr[i] = *(const u32x4*)(rp + 1536); vr[i] = *(const u32x4*)(rp + 3072); }
#pragma unroll
    for (int qi = 0; qi < 2; ++qi) { const bf16_t* qp = QKV + (a.tok0 + (size_t)(a.N0 + 32 * w + 16 * qi + fr) * a.d) * NQKV + a.qcol + 8 * G;
        qf[qi][0] = *(const bf16x8*)qp; qf[qi][1] = *(const bf16x8*)(qp + 32); }
}
__device__ __forceinline__ void attn_phase(bf16_t* QKV, float* LSE, const float* rel_table, LAS unsigned char* lds, int bx, int Gd, int tid) {
    const int lane = tid & 63, w = __builtin_amdgcn_readfirstlane(tid >> 6), fr = lane & 15, G = lane >> 4;
    {   int bk[9]; float tv[9];
#pragma unroll
        for (int k = 0; k < 9; ++k) { const int e = tid + 512 * k, gh = e / 192, rel = e - gh * 192 - 31; const int rc = rel < 0 ? 0 : (rel > 128 ? 128 : rel); bk[k] = (int)c_bucket[gh >> 3][rc] * 24 + gh; }
#pragma unroll
        for (int k = 0; k < 9; ++k) tv[k] = rel_table[bk[k]];
#pragma unroll
        for (int k = 0; k < 9; ++k) { const int e = tid + 512 * k, gh = e / 192, rel = e - gh * 192 - 31; ((LAS float*)(lds + ATT_LUT))[e] = (rel >= 0 && rel <= 128) ? tv[k] * LOG2E : -1e30f; }
    }
    u32x4 kr[6], vr[6]; bf16x8 qn[2][2];
    int unit = bx; AttnGeom a = attn_geom(unit);
    if (unit < 3072) attn_fetch(QKV, a, tid, kr, vr, qn);
    const float c1 = 0.125f * LOG2E;
    const int q4 = fr >> 2, p4 = fr & 3;
    for (; unit < 3072; unit += Gd) {
#pragma unroll
        for (int i = 0; i < 6; ++i) { const int ix = tid + 512 * i, row = ix >> 3, ch = ix & 7; const bool neg = (a.N0 - 128 + row) < 0;
            const u32x4 z = (u32x4){0u, 0u, 0u, 0u};
            *(LAS u32x4*)(lds + ATT_K + row * 128 + ((ch ^ kswz(row)) * 16)) = neg ? z : kr[i];
            *(LAS u32x4*)(lds + ATT_V + row * 128 + ((((ch >> 1) ^ ((row >> 1) & 3)) * 32) + (ch & 1) * 16)) = neg ? z : vr[i]; }
        bf16x8 qf[2][2];
#pragma unroll
        for (int qi = 0; qi < 2; ++qi) { qf[qi][0] = qn[qi][0]; qf[qi][1] = qn[qi][1]; }
        const AttnGeom c = a;
        lds_barrier();
        { const int nu = unit + Gd; if (nu < 3072) { a = attn_geom(nu); attn_fetch(QKV, a, tid, kr, vr, qn); } }
        f32x4 O[2][4]; float mrun[2], lsum[2];
#pragma unroll
        for (int qi = 0; qi < 2; ++qi) { mrun[qi] = -1e29f; lsum[qi] = 0.f;
#pragma unroll
            for (int cc = 0; cc < 4; ++cc) O[qi][cc] = (f32x4){0.f, 0.f, 0.f, 0.f}; }
        const LAS float* lut = (const LAS float*)(lds + ATT_LUT) + (c.g * 8 + c.h) * 192;
#pragma unroll 1
        for (int c5 = 0; c5 < 5; ++c5) {
            const int kbase = 32 * w + 32 * c5;
            bf16x8 kf[2][2];
#pragma unroll
            for (int kt = 0; kt < 2; ++kt) { const int row = kbase + 16 * kt + fr;
#pragma unroll
                for (int s2 = 0; s2 < 2; ++s2) kf[kt][s2] = *(const LAS bf16x8*)(lds + ATT_K + row * 128 + (((G + 4 * s2) ^ kswz(row)) * 16)); }
            bf16x8 vf[4];
#pragma unroll
            for (int cc = 0; cc < 4; ++cc) {
                const int r0 = kbase + 4 * G + q4, r1 = r0 + 16;
                const s16x4 lo = __builtin_bit_cast(s16x4, __builtin_amdgcn_ds_read_tr16_b64_v4i16((LAS s16x4*)(lds + ATT_V + r0 * 128 + ((cc ^ ((r0 >> 1) & 3)) * 32) + 8 * p4)));
                const s16x4 hi = __builtin_bit_cast(s16x4, __builtin_amdgcn_ds_read_tr16_b64_v4i16((LAS s16x4*)(lds + ATT_V + r1 * 128 + ((cc ^ ((r1 >> 1) & 3)) * 32) + 8 * p4)));
                vf[cc] = (bf16x8){lo[0], lo[1], lo[2], lo[3], hi[0], hi[1], hi[2], hi[3]}; }
            const bool edge = (c.qt == 0) && (kbase < 128);
#pragma unroll
            for (int qi = 0; qi < 2; ++qi) {
                f32x4 S[2];
#pragma unroll
                for (int kt = 0; kt < 2; ++kt) { S[kt] = __builtin_amdgcn_mfma_f32_16x16x32_bf16(kf[kt][0], qf[qi][0], (f32x4){0.f, 0.f, 0.f, 0.f}, 0, 0, 0);
                    S[kt] = __builtin_amdgcn_mfma_f32_16x16x32_bf16(kf[kt][1], qf[qi][1], S[kt], 0, 0, 0); }
                float mx = -1e30f;
#pragma unroll
                for (int kt = 0; kt < 2; ++kt)
#pragma unroll
                    for (int i = 0; i < 4; ++i) { const int li = 159 + 16 * qi + fr - 4 * G - 32 * c5 - 16 * kt - i;
                        float sv = S[kt][i] * c1 + lut[li];
                        if (edge && (kbase + 16 * kt + 4 * G + i) < 128) sv = -1e30f;
                        S[kt][i] = sv; mx = fmaxf(mx, sv); }
                mx = fmaxf(mx, __shfl_xor(mx, 16)); mx = fmaxf(mx, __shfl_xor(mx, 32));
                const float mnew = fmaxf(mrun[qi], mx), alpha = fast_exp2(mrun[qi] - mnew); mrun[qi] = mnew;
                float ps = 0.f;
#pragma unroll
                for (int kt = 0; kt < 2; ++kt)
#pragma unroll
                    for (int i = 0; i < 4; ++i) { const float p = fast_exp2(S[kt][i] - mnew); S[kt][i] = p; ps += p; }
                lsum[qi] = lsum[qi] * alpha + ps;
                u32x4 pw; pw.x = cvt_pk_bf16(S[0][0], S[0][1]); pw.y = cvt_pk_bf16(S[0][2], S[0][3]); pw.z = cvt_pk_bf16(S[1][0], S[1][1]); pw.w = cvt_pk_bf16(S[1][2], S[1][3]);
                const bf16x8 pf = __builtin_bit_cast(bf16x8, pw);
#pragma unroll
                for (int cc = 0; cc < 4; ++cc) { O[qi][cc] = O[qi][cc] * alpha; O[qi][cc] = __builtin_amdgcn_mfma_f32_16x16x32_bf16(vf[cc], pf, O[qi][cc], 0, 0, 0); }
            }
        }
#pragma unroll
        for (int qi = 0; qi < 2; ++qi) {
            float l = lsum[qi]; l += __shfl_xor(l, 16); l += __shfl_xor(l, 32);
            const float inv = 1.0f / l;
            const size_t tok = c.tok0 + (size_t)(c.N0 + 32 * w + 16 * qi + fr) * c.d;
            bf16_t* op = QKV + tok * NQKV + c.qcol + 4 * G;
#pragma unroll
            for (int cc = 0; cc < 4; ++cc) { u32x2 o; o.x = cvt_pk_bf16(O[qi][cc][0] * inv, O[qi][cc][1] * inv); o.y = cvt_pk_bf16(O[qi][cc][2] * inv, O[qi][cc][3] * inv); *(u32x2*)(op + 16 * cc) = o; }
            if (G == 0) LSE[(tok * 3 + c.g) * 8 + c.h] = mrun[qi] + __log2f(l);
        }
        lds_barrier();
    }
}
__device__ __forceinline__ void attn_combine(bf16_t* QKV, const float* LSE, int gtid, int NT, int ix_lo, int ix_hi) {
    for (int ix0 = ix_lo + gtid; ix0 < ix_hi; ix0 += 4 * NT) {
        float l[4][3]; u32x4 a[4][3];
#pragma unroll
        for (int r = 0; r < 4; ++r) { const int ix = ix0 + r * NT < ix_hi ? ix0 + r * NT : ix_hi - 1; const int tok = ix >> 6, h = (ix >> 3) & 7, ch = ix & 7;
            const bf16_t* qp = QKV + (size_t)tok * NQKV + h * 64 + ch * 8;
#pragma unroll
            for (int g = 0; g < 3; ++g) { l[r][g] = LSE[((size_t)tok * 3 + g) * 8 + h]; a[r][g] = *(const u32x4*)(qp + 512 * g); } }
#pragma unroll
        for (int r = 0; r < 4; ++r) { const int ix = ix0 + r * NT; const int tok = ix >> 6, h = (ix >> 3) & 7, ch = ix & 7;
            const float mx = fmaxf(l[r][0], fmaxf(l[r][1], l[r][2])); float w0 = fast_exp2(l[r][0] - mx), w1 = fast_exp2(l[r][1] - mx), w2 = fast_exp2(l[r][2] - mx); const float inv = 1.0f / (w0 + w1 + w2); w0 *= inv; w1 *= inv; w2 *= inv;
            u32x4 o;
#pragma unroll
            for (int j = 0; j < 4; ++j) { const float lo = w0 * bf_lo(a[r][0][j]) + w1 * bf_lo(a[r][1][j]) + w2 * bf_lo(a[r][2][j]), hi = w0 * bf_hi(a[r][0][j]) + w1 * bf_hi(a[r][1][j]) + w2 * bf_hi(a[r][2][j]); o[j] = cvt_pk_bf16(lo, hi); }
            if (ix < ix_hi) *(u32x4*)(QKV + (size_t)tok * NQKV + 1536 + h * 64 + ch * 8) = o; }
    }
}

template <int WIN> __device__ __forceinline__ void pool_strip(const bf16_t* Y, bf16_t* Z, int t0, int col) {
    const int spos0 = t0 & (SEQ - 1);
    u32x4 r[WIN + 7];
#pragma unroll
    for (int i = 0; i < WIN + 7; ++i) { const int rel = i - (WIN - 1); const bool ok = spos0 + rel >= 0; const int tok = ok ? t0 + rel : t0;
        r[i] = *(const u32x4*)(Y + (size_t)tok * D + col); if (!ok) r[i] = (u32x4){0u, 0u, 0u, 0u}; }
    float S[8];
#pragma unroll
    for (int c = 0; c < 8; ++c) S[c] = 0.f;
#pragma unroll
    for (int i = 0; i < WIN - 1; ++i)
#pragma unroll
        for (int c = 0; c < 4; ++c) { S[2 * c] += bf_lo(r[i][c]); S[2 * c + 1] += bf_hi(r[i][c]); }
#pragma unroll
    for (int j = 0; j < 8; ++j) { const u32x4 y = r[WIN - 1 + j];
#pragma unroll
        for (int c = 0; c < 4; ++c) { S[2 * c] += bf_lo(y[c]); S[2 * c + 1] += bf_hi(y[c]); }
        const int n = (spos0 + j + 1) < WIN ? (spos0 + j + 1) : WIN; const float inv = 1.0f / (float)n; u32x4 o;
#pragma unroll
        for (int c = 0; c < 4; ++c) o[c] = cvt_pk_bf16(S[2 * c] * inv - bf_lo(y[c]), S[2 * c + 1] * inv - bf_hi(y[c]));
        *(u32x4*)(Z + (size_t)(t0 + j) * D + col) = o;
        const u32x4 q = r[j];
#pragma unroll
        for (int c = 0; c < 4; ++c) { S[2 * c] -= bf_lo(q[c]); S[2 * c + 1] -= bf_hi(q[c]); } }
}
__device__ __forceinline__ void pool_phase(const bf16_t* Y, bf16_t* Z, int gw, int NGW, int lane, int it_lo, int it_hi) {
    for (int it = it_lo + gw; it < it_hi; it += NGW) { const int g = it & 3, sp = it >> 2; const int t0 = (sp * 2 + (lane >> 5)) * 8, col = g * 256 + (lane & 31) * 8;
        if (g == 0) pool_strip<2>(Y, Z, t0, col); else if (g == 1) pool_strip<4>(Y, Z, t0, col); else if (g == 2) pool_strip<8>(Y, Z, t0, col); else pool_strip<16>(Y, Z, t0, col); }
}

constexpr int SG_VN = 0, SG_WM = 65536, SG_ST = 98304;
__device__ __forceinline__ void sgu_unit(const bf16_t* Zc, bf16_t* Gt, const float* vgain, const float* w_s, const float* b_s, LAS unsigned char* lds, int chunk, int tid) {
    const int lane = tid & 63, w = __builtin_amdgcn_readfirstlane(tid >> 6), fr = lane & 15, G = lane >> 4;
    const size_t t0 = (size_t)chunk * 128;
    LAS float* st = (LAS float*)(lds + SG_ST);
    for (int i0 = 0; i0 < 16; i0 += 4) {
        u32x4 a[4], b2[4];
#pragma unroll
        for (int r = 0; r < 4; ++r) { const u32x4* vp = (const u32x4*)(Zc + (t0 + 16 * w + i0 + r) * 2048 + 1024) + lane; a[r] = vp[0]; b2[r] = vp[64]; }
#pragma unroll
        for (int r = 0; r < 4; ++r) { const int t = 16 * w + i0 + r; float x[16];
#pragma unroll
            for (int j = 0; j < 4; ++j) { x[2 * j] = bf_lo(a[r][j]); x[2 * j + 1] = bf_hi(a[r][j]); x[8 + 2 * j] = bf_lo(b2[r][j]); x[9 + 2 * j] = bf_hi(b2[r][j]); }
            float sm = 0.f;
#pragma unroll
            for (int j = 0; j < 16; ++j) sm += x[j];
            const float mu = wave_sum(sm) * (1.0f / 1024.0f); float q = 0.f;
#pragma unroll
            for (int j = 0; j < 16; ++j) { const float dd = x[j] - mu; q += dd * dd; }
            const float rstd = 1.0f / sqrtf(wave_sum(q) * (1.0f / 1024.0f) + EPS);
            if (lane == 0) { st[2 * t] = mu; st[2 * t + 1] = rstd; } }
    }
    lds_barrier();
    for (int g = 0; g < 4; ++g) {
#pragma unroll
        for (int i = 0; i < 8; ++i) { const int ix = tid + 512 * i, s = ix >> 5, ch = ix & 31, c0 = g * 256 + ch * 8;
            const u32x4 a = *(const u32x4*)(Zc + (t0 + s) * 2048 + 1024 + c0); const f32x4 g0 = *(const f32x4*)(vgain + c0), g1 = *(const f32x4*)(vgain + c0 + 4);
            const float mu = st[2 * s], rs = st[2 * s + 1]; u32x4 o;
            o.x = cvt_pk_bf16((bf_lo(a.x) - mu) * rs * g0.x, (bf_hi(a.x) - mu) * rs * g0.y); o.y = cvt_pk_bf16((bf_lo(a.y) - mu) * rs * g0.z, (bf_hi(a.y) - mu) * rs * g0.w);
            o.z = cvt_pk_bf16((bf_lo(a.z) - mu) * rs * g1.x, (bf_hi(a.z) - mu) * rs * g1.y); o.w = cvt_pk_bf16((bf_lo(a.w) - mu) * rs * g1.z, (bf_hi(a.w) - mu) * rs * g1.w);
            const int sw = (s & 3) | (((s >> 3) & 1) << 2);
            *(LAS u32x4*)(lds + SG_VN + s * 512 + ((((ch >> 1) ^ sw)) * 32) + (ch & 1) * 16) = o; }
#pragma unroll
        for (int i = 0; i < 4; ++i) { const int ix = tid + 512 * i, t = ix >> 4, ch = ix & 15, s0 = ch * 8;
            const float* wp = w_s + ((size_t)g * 128 + t) * 128 + s0; const f32x4 a = *(const f32x4*)wp, b2 = *(const f32x4*)(wp + 4); float x[8] = {a.x, a.y, a.z, a.w, b2.x, b2.y, b2.z, b2.w};
#pragma unroll
            for (int j = 0; j < 8; ++j) if (s0 + j > t) x[j] = 0.f;
            u32x4 o; o.x = cvt_pk_bf16(x[0], x[1]); o.y = cvt_pk_bf16(x[2], x[3]); o.z = cvt_pk_bf16(x[4], x[5]); o.w = cvt_pk_bf16(x[6], x[7]);
            *(LAS u32x4*)(lds + SG_WM + t * 256 + ((ch ^ (t & 15)) * 16)) = o; }
        lds_barrier();
        f32x4 acc[2][8];
#pragma unroll
        for (int ct = 0; ct < 2; ++ct)
#pragma unroll
            for (int tt = 0; tt < 8; ++tt) acc[ct][tt] = (f32x4){0.f, 0.f, 0.f, 0.f};
        const int q4 = fr >> 2, p4 = fr & 3;
#pragma unroll
        for (int sc = 0; sc < 4; ++sc) {
            bf16x8 af[2];
#pragma unroll
            for (int ct = 0; ct < 2; ++ct) { const int r0 = 32 * sc + 8 * G + q4, r1 = r0 + 4, u32 = 2 * w + ct;
                const int sw0 = (r0 & 3) | (((r0 >> 3) & 1) << 2), sw1 = (r1 & 3) | (((r1 >> 3) & 1) << 2);
                const s16x4 lo = __builtin_bit_cast(s16x4, __builtin_amdgcn_ds_read_tr16_b64_v4i16((LAS s16x4*)(lds + SG_VN + r0 * 512 + ((u32 ^ sw0) * 32) + 8 * p4)));
                const s16x4 hi = __builtin_bit_cast(s16x4, __builtin_amdgcn_ds_read_tr16_b64_v4i16((LAS s16x4*)(lds + SG_VN + r1 * 512 + ((u32 ^ sw1) * 32) + 8 * p4)));
                af[ct] = (bf16x8){lo[0], lo[1], lo[2], lo[3], hi[0], hi[1], hi[2], hi[3]}; }
#pragma unroll
            for (int tt = 0; tt < 8; ++tt) { const int t = 16 * tt + fr; const bf16x8 bfr = *(const LAS bf16x8*)(lds + SG_WM + t * 256 + (((4 * sc + G) ^ (t & 15)) * 16));
#pragma unroll
                for (int ct = 0; ct < 2; ++ct) acc[ct][tt] = __builtin_amdgcn_mfma_f32_16x16x32_bf16(af[ct], bfr, acc[ct][tt], 0, 0, 0); }
        }
#pragma unroll
        for (int tt = 0; tt < 8; ++tt) { const int t = 16 * tt + fr; const float bs = b_s[g * 128 + t];
#pragma unroll
            for (int ct = 0; ct < 2; ++ct) { const int c = g * 256 + 32 * w + 16 * ct + 4 * G; const u32x2 uu = *(const u32x2*)(Zc + (t0 + t) * 2048 + c);
                u32x2 o; o.x = cvt_pk_bf16(bf_lo(uu.x) * (acc[ct][tt][0] + bs), bf_hi(uu.x) * (acc[ct][tt][1] + bs)); o.y = cvt_pk_bf16(bf_lo(uu.y) * (acc[ct][tt][2] + bs), bf_hi(uu.y) * (acc[ct][tt][3] + bs));
                *(u32x2*)(Gt + (t0 + t) * 1024 + c) = o; } }
        lds_barrier();
    }
}

#define XB_TMO      128
#define XB_XCNT(j)  (256  + 64 * (j))
#define XB_XSUB(j)  (1280 + 64 * (j))
#define XB_XGEN(j)  (2304 + 64 * (j))
#define XB_TOP      3328
#define XB_TOPGEN   3392
#define XCD_BAR_WORDS 3456
#define XB_SPIN_CAP (1u << 18)

__device__ __forceinline__ unsigned xb_ld(unsigned* p)              { return __hip_atomic_load(p, __ATOMIC_RELAXED, __HIP_MEMORY_SCOPE_AGENT); }
__device__ __forceinline__ unsigned xb_add(unsigned* p, unsigned v) { return __hip_atomic_fetch_add(p, v, __ATOMIC_RELAXED, __HIP_MEMORY_SCOPE_AGENT); }
__device__ __forceinline__ unsigned xb_xcc_id() { return (unsigned)__builtin_amdgcn_s_getreg((3 << 11) | 20) & 0xFu; }
#define XB_SPIN(cond, bar) do { unsigned _sp = 0; while (cond) { __builtin_amdgcn_s_sleep(1); \
    if ((++_sp & 255u) == 0u) { if (xb_ld(&(bar)[XB_TMO])) break; if (_sp > XB_SPIN_CAP) { atomicAdd(&(bar)[XB_TMO], 1u); break; } } } } while (0)

struct XcdBarrier {
    unsigned* bar; unsigned x;
    volatile LAS unsigned* st;
};

__device__ __forceinline__ XcdBarrier xcd_barrier_post(unsigned* bar, volatile LAS unsigned* st) {
    XcdBarrier b; b.bar = bar; b.x = xb_xcc_id(); b.st = st;
    if (threadIdx.x == 0) st[2] = xb_add(&bar[XB_XCNT(b.x)], 1u);
    return b;
}
__device__ __forceinline__ void xcd_barrier_complete(unsigned* bar, unsigned x, unsigned& nloc, unsigned& nx) {
    const unsigned G = gridDim.x * gridDim.y * gridDim.z;
    unsigned sum, cnt, mine, sp = 0u;
    for (;;) {
        sum = 0u; cnt = 0u; mine = 0u;
#pragma unroll
        for (unsigned j = 0; j < 16; ++j) { const unsigned c = xb_ld(&bar[XB_XCNT(j)]); sum += c; cnt += (c > 0u) ? 1u : 0u; mine = (j == x) ? c : mine; }
        if (sum == G) break;
        __builtin_amdgcn_s_sleep(1);
        if ((++sp & 255u) == 0u) { if (xb_ld(&bar[XB_TMO])) break; if (sp > XB_SPIN_CAP) { atomicAdd(&bar[XB_TMO], 1u); break; } }
    }
    nloc = mine > 0u ? mine : 1u; nx = cnt > 0u ? cnt : 1u;
}
__device__ __forceinline__ unsigned xcd_census_uniform(unsigned* bar, unsigned nloc) {
    unsigned ok = 1u;
#pragma unroll
    for (unsigned j = 0; j < 16; ++j) { const unsigned c = xb_ld(&bar[XB_XCNT(j)]); if (c != (j < 8u ? nloc : 0u)) ok = 0u; }
    return ok;
}
#define XB_LSUB(j)  (4096 + 64 * (j))
#define XB_LGEN(j)  (5120 + 64 * (j))
#define XB_ALL_WORDS 6144
__device__ __forceinline__ void xcd_local_barrier(const XcdBarrier& b) {
    asm volatile("s_waitcnt vmcnt(0)" ::: "memory");
    __syncthreads();
    if (threadIdx.x == 0) {
        unsigned* bar = b.bar; const unsigned nloc = b.st[0];
        const unsigned old = xb_add(&bar[XB_LSUB(b.x)], 1u), gen = old / nloc;
        if (old + 1u == (gen + 1u) * nloc) xb_add(&bar[XB_LGEN(b.x)], 1u);
        else XB_SPIN(xb_ld(&bar[XB_LGEN(b.x)]) == gen, bar);
        __builtin_amdgcn_fence(__ATOMIC_ACQUIRE, "agent");
        asm volatile("s_waitcnt vmcnt(0)" ::: "memory");
    }
    __syncthreads();
}

__device__ __forceinline__ void xcd_barrier(const XcdBarrier& b) {
    asm volatile("s_waitcnt vmcnt(0)" ::: "memory");
    __syncthreads();
    if (threadIdx.x == 0) {
        unsigned* bar = b.bar;
        __builtin_amdgcn_s_waitcnt(0);
        unsigned nloc = b.st[0], nx = b.st[1];
        if (nloc == 0u) { xcd_barrier_complete(bar, b.x, nloc, nx); b.st[0] = nloc; b.st[1] = nx; b.st[3] = xcd_census_uniform(bar, nloc); }
        const unsigned old = xb_add(&bar[XB_XSUB(b.x)], 1u);
        const unsigned gen = old / nloc;
        if (old + 1u == (gen + 1u) * nloc) {
            __builtin_amdgcn_fence(__ATOMIC_RELEASE, "agent");
            asm volatile("s_waitcnt vmcnt(0)" ::: "memory");
            const unsigned og = xb_add(&bar[XB_TOP], 1u);
            const unsigned tg = og / nx;
            if (og + 1u == (tg + 1u) * nx) xb_add(&bar[XB_TOPGEN], 1u);
            else XB_SPIN(xb_ld(&bar[XB_TOPGEN]) == tg, bar);
            __builtin_amdgcn_fence(__ATOMIC_ACQUIRE, "agent");
            xb_add(&bar[XB_XGEN(b.x)], 1u);
            asm volatile("s_waitcnt vmcnt(0)" ::: "memory");
        } else {
            XB_SPIN(xb_ld(&bar[XB_XGEN(b.x)]) == gen, bar);
            __builtin_amdgcn_fence(__ATOMIC_ACQUIRE, "agent");
            asm volatile("s_waitcnt vmcnt(0)" ::: "memory");
        }
    }
    __syncthreads();
}

__device__ __forceinline__ void x_rows(const float* x, bf16_t* xb, pg8::ssq_t* ssq, int gw, int NGW, int lane) {
    for (int m0 = gw; m0 < M; m0 += 4 * NGW) {
        f32x4 v[4][4];
#pragma unroll
        for (int r = 0; r < 4; ++r) { const int m = m0 + r * NGW < M ? m0 + r * NGW : M - 1; const f32x4* xr = (const f32x4*)(x + (size_t)m * D) + lane;
#pragma unroll
            for (int j = 0; j < 4; ++j) v[r][j] = xr[64 * j]; }
#pragma unroll
        for (int r = 0; r < 4; ++r) { const int m = m0 + r * NGW; float s = 0.f;
#pragma unroll
            for (int j = 0; j < 4; ++j) s += (v[r][j].x * v[r][j].x + v[r][j].y * v[r][j].y) + (v[r][j].z * v[r][j].z + v[r][j].w * v[r][j].w);
            s = wave_sum(s);
            if (m < M) { u32x2* o8 = (u32x2*)(xb + (size_t)m * D) + lane;
#pragma unroll
                for (int j = 0; j < 4; ++j) { u32x2 w; w.x = cvt_pk_bf16(v[r][j].x, v[r][j].y); w.y = cvt_pk_bf16(v[r][j].z, v[r][j].w); o8[64 * j] = w; }
                if (lane == 0) ssq[m] = (pg8::ssq_t)(s * pg8::SSQ_SCALE); } }
    }
}

__global__ void __launch_bounds__(512, 2) fwd_kernel(Args args) {
    extern __shared__ __attribute__((aligned(16))) unsigned char lds_raw[];
    LAS unsigned char* lds = (LAS unsigned char*)lds_raw;
    if (threadIdx.x < 16) ((LAS unsigned*)(lds + 131072))[threadIdx.x] = 0u;
    __syncthreads();
    XcdBarrier xbar; xbar.bar = (unsigned*)(args.ws + WS_BAR); xbar.x = 0; xbar.st = (volatile LAS unsigned*)(lds + 131072);
    for (int ph = args.ph_lo; ph < args.ph_hi; ++ph) {
        const __attribute__((address_space(4))) Args* ap = (const __attribute__((address_space(4))) Args*)__builtin_amdgcn_kernarg_segment_ptr(); asm volatile("" : "+s"(ap));
        int tid = threadIdx.x; asm volatile("" : "+v"(tid));
        const int lane = tid & 63, wave = __builtin_amdgcn_readfirstlane(tid >> 6);
        int Gd = gridDim.x, bx = blockIdx.x; asm volatile("" : "+s"(Gd), "+s"(bx));
        const int gw = bx * 8 + wave, NGW = Gd * 8, gtid = bx * 512 + tid, NT = Gd * 512;
        unsigned char* ws = ap->ws; asm volatile("" : "+s"(ws)); ws = as_global(ws);
        bf16_t* PBF = (bf16_t*)(ws + WS_PBF); float* LSE = (float*)(ws + WS_LSE); bf16_t* BIG = (bf16_t*)(ws + WS_BIG);
        pg8::ssq_t* SSQ = (pg8::ssq_t*)(ws + WS_SSQ);
        float* H = as_global(ap->out);
        const int type = c_prog[ph][0], layer = c_prog[ph][1];
        int zoff = 0; asm volatile("" : "+v"(zoff));
        const volatile LAS unsigned* stw = (const volatile LAS unsigned*)(lds + 131072 + zoff);
        const bool uni = __builtin_amdgcn_readfirstlane((int)stw[3]) != 0 && Gd == 256;
        const int xrank = __builtin_amdgcn_readfirstlane((int)stw[2]), xcc = (int)xbar.x;
        bf16_t* HBin = (bf16_t*)(ws + (c_hb_in[layer] ? WS_X1 : WS_X0)); bf16_t* HBmid = (bf16_t*)(ws + (c_hb_mid[layer] ? WS_X1 : WS_X0)); bf16_t* HBoth = (bf16_t*)(ws + (c_hb_mid[layer] ? WS_X0 : WS_X1));
        pg8::Gemm gm{nullptr, nullptr, M, 0, 0, 0, 0, 0}; int epi = -1; bf16_t* ob = nullptr; int ldc = 0; const pg8::ssq_t* ssq_in = SSQ + (size_t)13 * M; pg8::ssq_t* ssq_out = nullptr; bf16_t* hbo = nullptr; const bf16_t* hbase = nullptr;
        bool second = false; bool conv_p = false;
        switch (type) {
#ifndef DIS_PRO
        case PT_PRO: {
            if (bx == 0 && ph == 0) for (int i = tid; i < XB_ALL_WORDS; i += 512) ((unsigned*)(ws + WS_BAR))[i] = 0u;
            unsigned cz = 0u, co = 1073740750u; asm volatile("" : "+v"(cz), "+v"(co));
            for (int i = gtid; i < 12 * M / 2; i += NT) ((u32x4*)(SSQ + M))[i] = (u32x4){cz, cz, cz, cz};
            for (int i = gtid; i < M / 2; i += NT) ((u32x4*)(SSQ + (size_t)13 * M))[i] = (u32x4){co, cz, co, cz};
            XposeCtx X{(LAS float*)(lds + wave * 16384), gw, NGW, lane, 0u};
            for (int j = 0; j < 2; ++j) {
                transpose_matrix<true>(X, as_global(ap->in[I_AQKV]) + (size_t)j * D * NQKV, D, NQKV, (bf16_t*)(ws + WS_WQKV) + (size_t)j * NQKV * D, 0, 0, as_global(ap->in[I_NMIX]) + (j ? 3 : 0) * D);
                transpose_matrix<false>(X, as_global(ap->in[I_AO]) + (size_t)j * 512 * D, 512, D, (bf16_t*)(ws + WS_WO) + (size_t)j * D * 512, 0, 0, nullptr);
            }
            transpose_matrix<true>(X, as_global(ap->in[I_BIN]), D, D, (bf16_t*)(ws + WS_BIN), 0, 0, as_global(ap->in[I_NMIX]) + 1 * D);
            for (int g = 0; g < 4; ++g) transpose_matrix<false>(X, as_global(ap->in[I_BGRP]) + (size_t)g * 65536, 256, 256, (bf16_t*)(ws + WS_BGRP), g * 256, 0, nullptr);
            transpose_matrix<true>(X, as_global(ap->in[I_BOUT]), D, D, (bf16_t*)(ws + WS_BOUT), 0, 0, as_global(ap->in[I_BSCALE]));
            transpose_matrix<true>(X, as_global(ap->in[I_CIN]), D, 2048, (bf16_t*)(ws + WS_CIN), 0, 0, as_global(ap->in[I_NMIX]) + 2 * D);
            transpose_matrix<false>(X, as_global(ap->in[I_COUT]), D, D, (bf16_t*)(ws + WS_COUT), 0, 0, nullptr);
            for (int i = 0; i < DEPTH; ++i) {
                transpose_matrix<true>(X, as_global(ap->in[I_FG]) + (size_t)i * D * FF, D, FF, (bf16_t*)(ws + WS_WGU) + (size_t)i * 2 * FF * D, 0, 1, as_global(ap->in[I_NFFN]) + i * D);
                transpose_matrix<true>(X, as_global(ap->in[I_FU]) + (size_t)i * D * FF, D, FF, (bf16_t*)(ws + WS_WGU) + (size_t)i * 2 * FF * D, 0, 2, as_global(ap->in[I_NFFN]) + i * D);
                transpose_matrix<false>(X, as_global(ap->in[I_FD]) + (size_t)i * FF * D, FF, D, (bf16_t*)(ws + WS_WDN) + (size_t)i * D * FF, 0, 0, nullptr);
                transpose_matrix<true>(X, as_global(ap->in[I_PG]) + (size_t)i * D * D, D, D, (bf16_t*)(ws + WS_WPG) + (size_t)i * D * D, 0, 0, as_global(ap->in[I_NPLE]) + i * D);
                transpose_matrix<false>(X, as_global(ap->in[I_PP]) + (size_t)i * PLE * D, PLE, D, (bf16_t*)(ws + WS_WPP) + (size_t)i * D * PLE, 0, 0, nullptr);
            }
            x_rows(as_global(ap->in[I_X]), (bf16_t*)(ws + WS_X0), SSQ, gw, NGW, lane);
            convert_p(as_global(ap->in[I_P]), PBF, gtid, NT);
        } break;
#endif
        case PT_FINAL: final_rows((const bf16_t*)(ws + WS_X1), as_global(ap->in[I_FNORM]), H, gw, NGW, lane); break;
        case PT_QKV: gm.A = HBin; gm.Bt = (bf16_t*)(ws + WS_WQKV) + (size_t)(layer / 3) * NQKV * D; gm.N = NQKV; gm.K = D; gm.lda = D; gm.ldb = D; epi = 0; ob = BIG; ldc = NQKV; ssq_in = SSQ + (size_t)(3 * layer) * M; conv_p = layer > 0; break;
#ifndef DIS_ATTN
        case PT_ATTN: attn_phase(BIG, LSE, as_global(ap->in[I_REL]), lds, bx, Gd, tid); break;
#endif
        case PT_COMB: attn_combine(BIG, LSE, uni ? xrank * 512 + tid : gtid, uni ? 32 * 512 : NT, uni ? xcc * (M * 8) : 0, uni ? (xcc + 1) * (M * 8) : M * 64); break;
        case PT_WO: gm.A = BIG + 1536; gm.Bt = (bf16_t*)(ws + WS_WO) + (size_t)(layer / 3) * D * 512; gm.N = D; gm.K = 512; gm.lda = NQKV; gm.ldb = 512; epi = 3; hbo = HBmid; ssq_out = SSQ + (size_t)(3 * layer + 1) * M; hbase = HBin; break;
        case PT_BIN: gm.A = HBin; gm.Bt = (bf16_t*)(ws + WS_BIN); gm.N = D; gm.K = D; gm.lda = D; gm.ldb = D; epi = 0; ob = BIG; ldc = D; ssq_in = SSQ + (size_t)(3 * layer) * M; conv_p = true; break;
        case PT_POOL: pool_phase(BIG, BIG + (size_t)M * D, uni ? xrank * 8 + wave : gw, uni ? 256 : NGW, lane, uni ? xcc * 1024 : 0, uni ? (xcc + 1) * 1024 : (M / 16) * 4); break;
        case PT_BGRP: gm.A = BIG + (size_t)M * D; gm.Bt = (bf16_t*)(ws + WS_BGRP); gm.N = D; gm.K = 256; gm.lda = D; gm.ldb = 256; gm.apn = 256; epi = 0; ob = BIG + (size_t)2 * M * D; ldc = D; break;
        case PT_BOUT: gm.A = BIG + (size_t)2 * M * D; gm.Bt = (bf16_t*)(ws + WS_BOUT); gm.N = D; gm.K = D; gm.lda = D; gm.ldb = D; epi = 3; hbo = HBmid; ssq_out = SSQ + (size_t)(3 * layer + 1) * M; hbase = HBin; break;
        case PT_CIN: gm.A = HBin; gm.Bt = (bf16_t*)(ws + WS_CIN); gm.N = 2048; gm.K = D; gm.lda = D; gm.ldb = D; epi = 1; ob = BIG; ldc = 2048; ssq_in = SSQ + (size_t)(3 * layer) * M; conv_p = true; break;
#ifndef DIS_SGU
        case PT_SGU: for (int u = uni ? xcc * 32 + xrank : bx; u < M / 128; u += Gd) sgu_unit(BIG, BIG + (size_t)M * 2048, as_global(ap->in[I_CVG]), as_global(ap->in[I_CWS]), as_global(ap->in[I_CBS]), lds, u, tid); break;
#endif
        case PT_COUT: gm.A = BIG + (size_t)M * 2048; gm.Bt = (bf16_t*)(ws + WS_COUT); gm.N = D; gm.K = D; gm.lda = D; gm.ldb = D; epi = 3; hbo = HBmid; ssq_out = SSQ + (size_t)(3 * layer + 1) * M; hbase = HBin; break;
        case PT_GU: gm.A = HBmid; gm.Bt = (bf16_t*)(ws + WS_WGU) + (size_t)layer * 2 * FF * D; gm.N = 2 * FF; gm.K = D; gm.lda = D; gm.ldb = D; epi = 2; ob = BIG; ldc = FF; ssq_in = SSQ + (size_t)(3 * layer + 1) * M; break;
        case PT_DOWN: gm.A = BIG; gm.Bt = (bf16_t*)(ws + WS_WDN) + (size_t)layer * D * FF; gm.N = D; gm.K = FF; gm.lda = FF; gm.ldb = FF; epi = 3; hbo = HBmid; ssq_out = SSQ + (size_t)(3 * layer + 2) * M; second = true; hbase = HBmid; break;
        case PT_PGATE: gm.A = HBmid; gm.Bt = (bf16_t*)(ws + WS_WPG) + (size_t)layer * D * D; gm.N = D; gm.K = D; gm.lda = D; gm.ldb = D; epi = 4; ssq_in = SSQ + (size_t)(3 * layer + 2) * M; ssq_out = SSQ + (size_t)(3 * layer + 3) * M; break;
        default: break;
        }
#ifndef DIS_GEMM
        if (epi >= 0) {
            int cv = bx;
            if (uni) cv = xrank * 8 + xcc;
            pg8::StaticOrder S; S.init(M, gm.N, Gd, cv);
#ifdef ONLY_EPI
            if (epi != ONLY_EPI) epi = 99;
#endif
            if (epi == 99) {} else
            if (epi == 0) { pg8::EpiBf16<0> E{ob, ldc, ssq_in}; pg8::gemm_phase<pg8::EpiBf16<0>, true>(lds, gm, S, E, tid); }
            else if (epi == 1) { pg8::EpiBf16<1> E{ob, ldc, ssq_in}; pg8::gemm_phase<pg8::EpiBf16<1>, true>(lds, gm, S, E, tid); }
            else if (epi == 2) { pg8::EpiSwiGLU E{ob, ldc, ssq_in}; pg8::gemm_phase<pg8::EpiSwiGLU, true>(lds, gm, S, E, tid); }
            else if (epi == 3) { pg8::EpiRes E{hbase, hbo, ssq_out}; pg8::gemm_phase<pg8::EpiRes, false>(lds, gm, S, E, tid); }
            else { pg8::EpiPle E{HBmid, HBoth, ssq_in, ssq_out}; pg8::gemm_phase<pg8::EpiPle, false>(lds, gm, S, E, tid); }
        }
        if (second) {
            pg8::Gemm g2{PBF, (bf16_t*)(ws + WS_WPP) + (size_t)layer * D * PLE, M, D, PLE, PLE, PLE, 0};
            const int cv = uni ? xrank * 8 + xcc : bx;
            pg8::StaticOrder S; S.init(M, D, Gd, cv);
            pg8::EpiBf16<0> E{HBoth, D, SSQ + (size_t)13 * M}; pg8::gemm_phase<pg8::EpiBf16<0>, true>(lds, g2, S, E, tid);
        }
#endif
        if (conv_p) convert_p(as_global(ap->in[I_P]) + (size_t)layer * M * PLE, PBF, gtid, NT);
        if (ph + 1 < args.ph_hi) {
            if (ph == 0) { cg::this_grid().sync(); xbar = xcd_barrier_post((unsigned*)(args.ws + WS_BAR), (volatile LAS unsigned*)(lds + 131072)); }
            else {
                const bool loc = uni && (type == PT_GU || type == PT_DOWN || type == PT_COMB || type == PT_POOL || type == PT_BGRP || type == PT_CIN || type == PT_SGU);
                if (loc) xcd_local_barrier(xbar); else xcd_barrier(xbar);
            }
        }
    }
}

extern "C" void kernel_launch(void* const* d_in, const int* in_sizes, int n_in, void* d_out, int out_size, void* d_ws, size_t ws_size, hipStream_t stream) {
    static int grid = 0;
    if (grid == 0) {
        if (n_in != 23 || out_size != M * D || ws_size < WS_END) { fprintf(stderr, "kernel_launch: unexpected problem (n_in %d, out %d, ws %zu < %zu)\n", n_in, out_size, ws_size, (size_t)WS_END); grid = -1; return; }
        int dev = 0, cus = 0, per_cu = 0;
        hipGetDevice(&dev); hipDeviceGetAttribute(&cus, hipDeviceAttributeMultiprocessorCount, dev);
        if (hipFuncSetAttribute((const void*)fwd_kernel, hipFuncAttributeMaxDynamicSharedMemorySize, LDS_BYTES) != hipSuccess) { fprintf(stderr, "kernel_launch: hipFuncSetAttribute failed\n"); grid = -1; return; }
        if (hipOccupancyMaxActiveBlocksPerMultiprocessor(&per_cu, (const void*)fwd_kernel, 512, LDS_BYTES) != hipSuccess || per_cu < 1) { fprintf(stderr, "kernel_launch: occupancy query says %d blocks/CU\n", per_cu); per_cu = 1; }
        (void)hipGetLastError();
        grid = cus;
    }
    if (grid < 0) return;
    Args a{};
    for (int i = 0; i < 23; ++i) a.in[i] = (const float*)d_in[i];
    a.out = (float*)d_out; a.ws = (unsigned char*)d_ws;
#if MK_PER_PHASE
    for (int ph = 0; ph < NPHASE; ++ph) { a.ph_lo = ph; a.ph_hi = ph + 1; hipLaunchKernelGGL(fwd_kernel, dim3(grid), dim3(512), LDS_BYTES, stream, a); }
#else
    a.ph_lo = 0; a.ph_hi = NPHASE;
    void* kargs[] = {&a};
    hipError_t e = hipLaunchCooperativeKernel((const void*)fwd_kernel, dim3(grid), dim3(512), kargs, LDS_BYTES, stream);
    if (e != hipSuccess) fprintf(stderr, "cooperative launch failed: %s (grid %d)\n", hipGetErrorString(e), grid);
#endif
}
```

```cpp
#include <hip/hip_runtime.h>
#include <hip/hip_cooperative_groups.h>
#include <cstdio>
#include <cstdint>
namespace cg = cooperative_groups;

#ifndef MK_PER_PHASE
#define MK_PER_PHASE 0
#endif

#define LAS __attribute__((address_space(3)))
typedef unsigned short bf16_t;
typedef short bf16x8 __attribute__((ext_vector_type(8)));
typedef short s16x4 __attribute__((ext_vector_type(4)));
typedef float f32x4 __attribute__((ext_vector_type(4)));
typedef float f32x2 __attribute__((ext_vector_type(2)));
typedef unsigned u32x4 __attribute__((ext_vector_type(4)));
typedef unsigned u32x2 __attribute__((ext_vector_type(2)));

constexpr int D = 1024, BATCH = 4, SEQ = 8192, M = BATCH * SEQ, DEPTH = 4;
constexpr int NQKV = 4608, FF = 2816, PLE = 256;
constexpr float EPS = 1e-6f;
constexpr float LOG2E = 1.4426950408889634f;

__device__ __forceinline__ unsigned cvt_pk_bf16(float lo, float hi) { unsigned r; asm volatile("v_cvt_pk_bf16_f32 %0, %1, %2" : "=v"(r) : "v"(lo), "v"(hi)); return r; }
__device__ __forceinline__ float bf_lo(unsigned u) { return __uint_as_float(u << 16); }
__device__ __forceinline__ float bf_hi(unsigned u) { return __uint_as_float(u & 0xffff0000u); }
__device__ __forceinline__ float fast_exp2(float x) { return __builtin_amdgcn_exp2f(x); }
__device__ __forceinline__ float fast_rcp(float x) { return __builtin_amdgcn_rcpf(x); }
__device__ __forceinline__ float sigmoidf_(float x) { return fast_rcp(1.0f + fast_exp2(-LOG2E * x)); }
__device__ __forceinline__ float siluf_(float x) { return x * sigmoidf_(x); }
__device__ __forceinline__ float gelu_tanh(float x) { const float u = 0.7978845608028654f * (x + 0.044715f * x * x * x); return x * fast_rcp(1.0f + fast_exp2(-2.0f * LOG2E * u)); }
__device__ __forceinline__ void lds_barrier() { asm volatile("s_waitcnt lgkmcnt(0)\n\ts_barrier" ::: "memory"); }
__device__ __forceinline__ float wave_sum(float v) {
#pragma unroll
    for (int o = 1; o < 64; o <<= 1) v += __shfl_xor(v, o);
    return v;
}

template <class T> __device__ __forceinline__ T* as_global(T* p) { __attribute__((address_space(1))) T* g = (__attribute__((address_space(1))) T*)p; asm volatile("" : "+s"(g)); return (T*)g; }

namespace pg8 {
constexpr int BM = 256, BK = 64, HALF = 128, HTB = HALF * BK * 2, STAGE_BYTES = 8 * HTB, NXCD = 8, WGM = 8;
__host__ __device__ __forceinline__ int lds_byte(int r, int c) { const int st = (r >> 4) * 2 + (c >> 5), rr = r & 15, cc = c & 31, ob = rr * 64 + cc * 2; return st * 1024 + (ob ^ (((ob >> 9) & 1) << 5)); }
__host__ __device__ __forceinline__ void stage_rc(int b, int& R, int& C) { const int st = b / 1024, sb = b % 1024, swz = sb ^ (((sb >> 9) & 1) << 5); R = (st >> 1) * 16 + swz / 64; C = (st & 1) * 32 + (swz % 64) / 2; }
__host__ __device__ __forceinline__ int perm32(int rho) { const int n = rho >> 4, i = rho & 15; return 8 * (i >> 2) + 4 * n + (i & 3); }

struct Unit { int pm, pn; };
struct Gemm { const bf16_t* A; const bf16_t* Bt; int M, N, K, lda, ldb, apn; };

struct StaticOrder {
    int nM, nN, nwg, G, c;
    __device__ void init(int M_, int N_, int G_, int c_) { nM = M_ / BM; nN = N_ / BM; nwg = nM * nN; G = G_; c = c_; }
    __device__ bool next(int i, Unit& u) const {
        const long L = (long)i * G + c; if (L >= nwg) return false;
        int wgid = (int)L; { const int q = nwg / NXCD, r = nwg % NXCD, xcd = wgid % NXCD, off = wgid / NXCD; wgid = (xcd < r ? xcd * (q + 1) : r * (q + 1) + (xcd - r) * q) + off; }
        const int nig = WGM * nN, gid = wgid / nig, fm = gid * WGM, gsz = (nM - fm) < WGM ? (nM - fm) : WGM;
        u.pm = fm + ((wgid % nig) % gsz); u.pn = (wgid % nig) / gsz; return true;
    }
};

typedef unsigned long long ssq_t;
constexpr float SSQ_SCALE = 1048576.0f, SSQ_INV = 1.0f / 1048576.0f;
__device__ __forceinline__ void load_rstd(float (&rsv)[2][4], const ssq_t* ssq, int row0) {
    ssq_t t[2][4];
#pragma unroll
    for (int ai = 0; ai < 2; ++ai)
#pragma unroll
        for (int m = 0; m < 4; ++m) t[ai][m] = ssq[row0 + ai * HALF + m * 16];
#pragma unroll
    for (int ai = 0; ai < 2; ++ai)
#pragma unroll
        for (int m = 0; m < 4; ++m) rsv[ai][m] = __builtin_amdgcn_rsqf((float)t[ai][m] * (SSQ_INV / 1024.0f) + 1e-6f);
}
__device__ __forceinline__ void ssq_add(ssq_t* p, float v) { __hip_atomic_fetch_add((__attribute__((address_space(1))) ssq_t*)p, (ssq_t)(v * SSQ_SCALE), __ATOMIC_RELAXED, __HIP_MEMORY_SCOPE_AGENT); }
template <int ACT> struct EpiBf16 {
    static constexpr bool PERM = true;
    bf16_t* O; int ldc; const ssq_t* ssq;
    __device__ __forceinline__ void operator()(const f32x4 (&acc)[2][2][4][2], const Unit& u, int wr, int wc, int fr, int fq) const {
        const int row0 = u.pm * BM + wr * 64 + fr, col0 = u.pn * BM + wc * 32 + 8 * fq;
        float rsv[2][4]; load_rstd(rsv, ssq, row0);
#pragma unroll
        for (int ai = 0; ai < 2; ++ai)
#pragma unroll
            for (int m = 0; m < 4; ++m) { const int row = row0 + ai * HALF + m * 16; bf16_t* rowp = O + (size_t)row * ldc + col0; const float rs = rsv[ai][m];
#pragma unroll
                for (int bj = 0; bj < 2; ++bj) { f32x4 v0 = acc[ai][bj][m][0] * rs, v1 = acc[ai][bj][m][1] * rs;
                    if (ACT == 1) {
#pragma unroll
                        for (int j = 0; j < 4; ++j) { v0[j] = gelu_tanh(v0[j]); v1[j] = gelu_tanh(v1[j]); } }
                    u32x4 w; w.x = cvt_pk_bf16(v0[0], v0[1]); w.y = cvt_pk_bf16(v0[2], v0[3]); w.z = cvt_pk_bf16(v1[0], v1[1]); w.w = cvt_pk_bf16(v1[2], v1[3]);
                    *(u32x4*)(rowp + bj * HALF) = w; } }
    }
};
struct EpiSwiGLU {
    static constexpr bool PERM = true;
    bf16_t* O; int ldc; const ssq_t* ssq;
    __device__ __forceinline__ void operator()(const f32x4 (&acc)[2][2][4][2], const Unit& u, int wr, int wc, int fr, int fq) const {
        const int row0 = u.pm * BM + wr * 64 + fr, col0 = u.pn * HALF + wc * 32 + 8 * fq;
        float rsv[2][4]; load_rstd(rsv, ssq, row0);
#pragma unroll
        for (int ai = 0; ai < 2; ++ai)
#pragma unroll
            for (int m = 0; m < 4; ++m) { const int row = row0 + ai * HALF + m * 16; bf16_t* rowp = O + (size_t)row * ldc + col0; const float rs = rsv[ai][m];
                f32x4 v0, v1;
#pragma unroll
                for (int j = 0; j < 4; ++j) { v0[j] = siluf_(acc[ai][0][m][0][j] * rs) * (acc[ai][1][m][0][j] * rs); v1[j] = siluf_(acc[ai][0][m][1][j] * rs) * (acc[ai][1][m][1][j] * rs); }
                u32x4 w; w.x = cvt_pk_bf16(v0[0], v0[1]); w.y = cvt_pk_bf16(v0[2], v0[3]); w.z = cvt_pk_bf16(v1[0], v1[1]); w.w = cvt_pk_bf16(v1[2], v1[3]);
                *(u32x4*)rowp = w; }
    }
};
#define ER_OFF(q, bj) (off0 + (unsigned)((((q) >> 2) * HALF + ((q) & 3) * 16) * 1024 + (bj) * HALF))
#define ER_STORE(q) do { float sq = 0.f; \
            _Pragma("unroll") for (int bj = 0; bj < 2; ++bj) { const unsigned o = ER_OFF(q, bj); const f32x4 r0 = acc[(q) >> 2][bj][(q) & 3][0], r1 = acc[(q) >> 2][bj][(q) & 3][1]; \
                u32x4 w; w.x = cvt_pk_bf16(r0[0], r0[1]); w.y = cvt_pk_bf16(r0[2], r0[3]); w.z = cvt_pk_bf16(r1[0], r1[1]); w.w = cvt_pk_bf16(r1[2], r1[3]); \
                *(u32x4*)(hb + o) = w; \
                _Pragma("unroll") for (int j = 0; j < 4; ++j) { const float a = bf_lo(w[j]), b = bf_hi(w[j]); sq += a * a + b * b; } } \
            sq += __shfl_xor(sq, 16); sq += __shfl_xor(sq, 32); \
            if (fq == 0) ssq_add(ssq_out + row0 + ((q) >> 2) * HALF + ((q) & 3) * 16, sq); } while (0)
struct EpiRes {
    static constexpr bool PERM = true;
    const bf16_t* base; bf16_t* hb; ssq_t* ssq_out;
    __device__ __forceinline__ void operator()(f32x4 (&acc)[2][2][4][2], const Unit& u, int wr, int wc, int fr, int fq) const {
        const int row0 = u.pm * BM + wr * 64 + fr, col0 = u.pn * BM + wc * 32 + 8 * fq; const unsigned off0 = (unsigned)row0 * 1024u + (unsigned)col0;
        u32x4 t[4][2];
#define ER_LOAD(q) do { _Pragma("unroll") for (int bj = 0; bj < 2; ++bj) t[(q) & 3][bj] = *(const u32x4*)(base + ER_OFF(q, bj)); } while (0)
#define ER_ADD(q) do { _Pragma("unroll") for (int bj = 0; bj < 2; ++bj) { f32x4& a0 = acc[(q) >> 2][bj][(q) & 3][0]; f32x4& a1 = acc[(q) >> 2][bj][(q) & 3][1]; const u32x4 p = t[(q) & 3][bj]; \
            a0[0] += bf_lo(p.x); a0[1] += bf_hi(p.x); a0[2] += bf_lo(p.y); a0[3] += bf_hi(p.y); a1[0] += bf_lo(p.z); a1[1] += bf_hi(p.z); a1[2] += bf_lo(p.w); a1[3] += bf_hi(p.w); } } while (0)
#pragma unroll
        for (int q = 0; q < 4; ++q) ER_LOAD(q);
#pragma unroll
        for (int q = 0; q < 4; ++q) ER_ADD(q);
#pragma unroll
        for (int q = 4; q < 8; ++q) ER_LOAD(q);
#pragma unroll
        for (int q = 0; q < 4; ++q) ER_STORE(q);
#pragma unroll
        for (int q = 4; q < 8; ++q) { ER_ADD(q); ER_STORE(q); }
#undef ER_LOAD
#undef ER_ADD
    }
};
struct EpiPle {
    static constexpr bool PERM = true;
    const bf16_t* base; bf16_t* pp; const ssq_t* ssq; ssq_t* ssq_out;
    __device__ __forceinline__ void operator()(f32x4 (&acc)[2][2][4][2], const Unit& u, int wr, int wc, int fr, int fq) const {
        const int row0 = u.pm * BM + wr * 64 + fr, col0 = u.pn * BM + wc * 32 + 8 * fq; const unsigned off0 = (unsigned)row0 * 1024u + (unsigned)col0;
        float rsv[2][4]; load_rstd(rsv, ssq, row0);
        u32x4 t[2][2], pw[2][2];
#define EP_LOAD(q) do { _Pragma("unroll") for (int bj = 0; bj < 2; ++bj) { const unsigned o = ER_OFF(q, bj); t[(q) & 1][bj] = *(const u32x4*)(base + o); pw[(q) & 1][bj] = *(const u32x4*)(pp + o); } } while (0)
#define EP_ADD(q) do { _Pragma("unroll") for (int bj = 0; bj < 2; ++bj) { const float rs = rsv[(q) >> 2][(q) & 3]; const f32x4 a0 = acc[(q) >> 2][bj][(q) & 3][0] * rs, a1 = acc[(q) >> 2][bj][(q) & 3][1] * rs; const u32x4 p = pw[(q) & 1][bj], b = t[(q) & 1][bj]; f32x4 r0, r1; \
            r0[0] = bf_lo(b.x) + bf_lo(p.x) * sigmoidf_(a0[0]); r0[1] = bf_hi(b.x) + bf_hi(p.x) * sigmoidf_(a0[1]); r0[2] = bf_lo(b.y) + bf_lo(p.y) * sigmoidf_(a0[2]); r0[3] = bf_hi(b.y) + bf_hi(p.y) * sigmoidf_(a0[3]); \
            r1[0] = bf_lo(b.z) + bf_lo(p.z) * sigmoidf_(a1[0]); r1[1] = bf_hi(b.z) + bf_hi(p.z) * sigmoidf_(a1[1]); r1[2] = bf_lo(b.w) + bf_lo(p.w) * sigmoidf_(a1[2]); r1[3] = bf_hi(b.w) + bf_hi(p.w) * sigmoidf_(a1[3]); \
            acc[(q) >> 2][bj][(q) & 3][0] = r0; acc[(q) >> 2][bj][(q) & 3][1] = r1; } } while (0)
        bf16_t* hb = pp;
        EP_LOAD(0); EP_LOAD(1); EP_ADD(0); EP_ADD(1);
#pragma unroll
        for (int q = 0; q < 8; q += 2) { if (q < 6) { EP_LOAD(q + 2); EP_LOAD(q + 3); } ER_STORE(q); ER_STORE(q + 1); if (q < 6) { EP_ADD(q + 2); EP_ADD(q + 3); } }
#undef EP_LOAD
#undef EP_ADD
    }
};
#undef ER_STORE
#undef ER_OFF

template <class Epi, bool ALIGN_EPI>
__device__ __forceinline__ void gemm_phase(LAS unsigned char* lds, const Gemm g, const StaticOrder& S, const Epi& E, const int tid) {
    const int wid = __builtin_amdgcn_readfirstlane(tid >> 6), lane = tid & 63, wr = wid >> 2, wc = wid & 3, fr = lane & 15, fq = lane >> 4;
    const int K = g.K, nt = K / BK;
    unsigned voffA[2], voffB[2];
#pragma unroll
    for (int i = 0; i < 2; ++i) { int R, C; stage_rc(tid * 16 + i * 8192, R, C); const int Rb = Epi::PERM ? ((R & ~31) + perm32(R & 31)) : R;
        voffA[i] = (unsigned)(R * g.lda + C) * 2u; voffB[i] = (unsigned)(Rb * g.ldb + C) * 2u; }
    const size_t kstep = (size_t)(BK * 2);
    const size_t hA = (size_t)HALF * g.lda * 2, hB = (size_t)HALF * g.ldb * 2, tA = 2 * hA, tB = 2 * hB;
    const unsigned ldsw = (unsigned)wid * 1024u;
    const int aoff = lds_byte(wr * 64 + fr, fq * 8), boff = lds_byte(wc * 32 + fr, fq * 8);
#define PG8_SA(b, h) (((b) * 2 + (h)) * HTB)
#define PG8_SB(b, h) ((4 + (b) * 2 + (h)) * HTB)
#define PG8_STAGE(bufoff, gbase, voff) do { _Pragma("unroll") for (int _i = 0; _i < 2; ++_i) \
        __builtin_amdgcn_global_load_lds((const unsigned*)((const char*)(gbase) + (voff)[_i]), (LAS unsigned*)(lds + (bufoff) + ldsw + _i * 8192), 16, 0, 0); } while (0)
#define PG8_LDA(dst, b, h) do { _Pragma("unroll") for (int m = 0; m < 4; ++m) _Pragma("unroll") for (int k = 0; k < 2; ++k) dst[m][k] = *(const LAS bf16x8*)(lds + PG8_SA(b, h) + aoff + m * 2048 + k * 1024); } while (0)
#define PG8_LDB(dst, b, h) do { _Pragma("unroll") for (int n = 0; n < 2; ++n) _Pragma("unroll") for (int k = 0; k < 2; ++k) dst[n][k] = *(const LAS bf16x8*)(lds + PG8_SB(b, h) + boff + n * 2048 + k * 1024); } while (0)
#define PG8_MMA(ai, bj, At, Bt) do { __builtin_amdgcn_s_setprio(1); _Pragma("unroll") for (int k = 0; k < 2; ++k) _Pragma("unroll") for (int m = 0; m < 4; ++m) _Pragma("unroll") for (int n = 0; n < 2; ++n) \
        acc[ai][bj][m][n] = __builtin_amdgcn_mfma_f32_16x16x32_bf16(Bt[n][k], At[m][k], acc[ai][bj][m][n], 0, 0, 0); __builtin_amdgcn_s_setprio(0); } while (0)
#define PG8_WAIT_V(n) asm volatile("s_waitcnt vmcnt(" #n ")" ::: "memory")
#define PG8_WAIT_L(n) asm volatile("s_waitcnt lgkmcnt(" #n ")" ::: "memory")
#define PG8_BAR __builtin_amdgcn_s_barrier()
#define PG8_SCHED __builtin_amdgcn_sched_barrier(0)
    Unit cur, nxt; int ui = 0;
    if (!S.next(0, cur)) return;
    f32x4 acc[2][2][4][2];
#pragma unroll
    for (int a = 0; a < 2; ++a)
#pragma unroll
        for (int b = 0; b < 2; ++b)
#pragma unroll
            for (int m = 0; m < 4; ++m)
#pragma unroll
                for (int n = 0; n < 2; ++n) acc[a][b][m][n] = (f32x4){0.f, 0.f, 0.f, 0.f};
    bf16x8 At[4][2], B0[2][2], B1[2][2];
    const char* cA = (const char*)g.A + (size_t)cur.pm * tA + (size_t)cur.pn * g.apn * 2; const char* cB = (const char*)g.Bt + (size_t)cur.pn * tB;
    PG8_STAGE(PG8_SB(0, 0), cB, voffB); PG8_STAGE(PG8_SB(0, 1), cB + hB, voffB); PG8_STAGE(PG8_SA(0, 0), cA, voffA); PG8_STAGE(PG8_SA(0, 1), cA + hA, voffA);
    if (wr == 1) PG8_BAR;
    PG8_WAIT_V(2); PG8_BAR;
    PG8_STAGE(PG8_SB(1, 0), cB + kstep, voffB); PG8_STAGE(PG8_SA(1, 0), cA + kstep, voffA); PG8_STAGE(PG8_SB(1, 1), cB + hB + kstep, voffB);
    PG8_WAIT_V(6); PG8_BAR;
    for (;;) {
        const bool has_next = S.next(ui + 1, nxt);
        const char* nA = has_next ? (const char*)g.A + (size_t)nxt.pm * tA + (size_t)nxt.pn * g.apn * 2 : cA; const char* nB = has_next ? (const char*)g.Bt + (size_t)nxt.pn * tB : cB;
        for (int t = 0; t < nt; t += 2) {
            const bool last = (t == nt - 2);
            const char* a1 = cA + (size_t)(t + 1) * kstep;
            const char* a2 = last ? nA : cA + (size_t)(t + 2) * kstep; const char* b2 = last ? nB : cB + (size_t)(t + 2) * kstep;
            const char* a3 = a2 + kstep; const char* b3 = b2 + kstep;
            PG8_LDB(B0, 0, 0); PG8_LDB(B1, 0, 1); PG8_SCHED; PG8_LDA(At, 0, 0); PG8_STAGE(PG8_SA(1, 1), a1 + hA, voffA);
            PG8_WAIT_V(8); PG8_WAIT_L(0); PG8_BAR; PG8_MMA(0, 0, At, B0); PG8_MMA(0, 1, At, B1); PG8_BAR; PG8_SCHED;
            PG8_LDA(At, 0, 1); PG8_STAGE(PG8_SB(0, 0), b2, voffB); PG8_STAGE(PG8_SB(0, 1), b2 + hB, voffB); PG8_STAGE(PG8_SA(0, 0), a2, voffA);
            PG8_WAIT_V(8); PG8_WAIT_L(0); PG8_BAR; PG8_MMA(1, 0, At, B0); PG8_MMA(1, 1, At, B1); PG8_BAR; PG8_SCHED;
            PG8_LDB(B0, 1, 0); PG8_LDB(B1, 1, 1); PG8_SCHED; PG8_LDA(At, 1, 0); PG8_STAGE(PG8_SA(0, 1), a2 + hA, voffA);
            PG8_WAIT_V(8); PG8_WAIT_L(0); PG8_BAR; PG8_MMA(0, 0, At, B0); PG8_MMA(0, 1, At, B1); PG8_BAR; PG8_SCHED;
            PG8_LDA(At, 1, 1); PG8_STAGE(PG8_SB(1, 0), b3, voffB); PG8_STAGE(PG8_SB(1, 1), b3 + hB, voffB); PG8_STAGE(PG8_SA(1, 0), a3, voffA);
            PG8_WAIT_V(8); PG8_WAIT_L(0); PG8_BAR; PG8_MMA(1, 0, At, B0); PG8_MMA(1, 1, At, B1); PG8_BAR; PG8_SCHED;
        }
        if constexpr (ALIGN_EPI) { if (wr == 0) PG8_BAR; }
        { int t2 = tid; asm volatile("" : "+v"(t2)); const int l2 = t2 & 63, w2 = __builtin_amdgcn_readfirstlane(t2 >> 6); E(acc, cur, w2 >> 2, w2 & 3, l2 & 15, l2 >> 4); }
        if (!has_next) break;
#pragma unroll
        for (int a = 0; a < 2; ++a)
#pragma unroll
            for (int b = 0; b < 2; ++b)
#pragma unroll
                for (int m = 0; m < 4; ++m)
#pragma unroll
                    for (int n = 0; n < 2; ++n) acc[a][b][m][n] = (f32x4){0.f, 0.f, 0.f, 0.f};
        cur = nxt; cA = nA; cB = nB; ++ui;
        if constexpr (ALIGN_EPI) { if (wr == 1) PG8_BAR; }
    }
    PG8_WAIT_V(0);
    if constexpr (!ALIGN_EPI) { if (wr == 0) PG8_BAR; }
    PG8_BAR;
#undef PG8_SA
#undef PG8_SB
#undef PG8_STAGE
#undef PG8_LDA
#undef PG8_LDB
#undef PG8_MMA
#undef PG8_WAIT_V
#undef PG8_WAIT_L
#undef PG8_BAR
#undef PG8_SCHED
}
}

constexpr size_t MiB = 1u << 20;
constexpr size_t WS_BAR  = 0;
constexpr size_t WS_WQKV = 2 * MiB;
constexpr size_t WS_WO   = WS_WQKV + 18 * MiB;
constexpr size_t WS_BIN  = WS_WO + 2 * MiB;
constexpr size_t WS_BGRP = WS_BIN + 2 * MiB;
constexpr size_t WS_BOUT = WS_BGRP + MiB / 2;
constexpr size_t WS_CIN  = WS_BOUT + 2 * MiB;
constexpr size_t WS_COUT = WS_CIN + 4 * MiB;
constexpr size_t WS_WGU  = WS_COUT + 2 * MiB;
constexpr size_t WS_WDN  = WS_WGU + 44 * MiB;
constexpr size_t WS_WPG  = WS_WDN + 22 * MiB;
constexpr size_t WS_WPP  = WS_WPG + 8 * MiB;
constexpr size_t WS_X0   = WS_WPP + 2 * MiB;
constexpr size_t WS_PBF  = WS_X0 + 64 * MiB;
constexpr size_t WS_LSE  = WS_PBF + 16 * MiB;
constexpr size_t WS_BIG  = WS_LSE + 3 * MiB;
constexpr size_t WS_X1   = WS_BIG + 224 * MiB;
constexpr size_t WS_SSQ  = WS_BIG + 288 * MiB;
constexpr size_t WS_END  = WS_SSQ + 4 * MiB;
static_assert(WS_END <= 512 * MiB, "workspace map");

constexpr int LDS_BYTES = 147456;

__constant__ unsigned char c_bucket[3][132] = {
 {0,1,2,3,4,5,6,7,8,9,10,11,12,13,14,15,16,16,16,16,16,16,17,17,17,17,17,17,17,17,18,18,18,18,18,18,18,18,18,18,19,19,19,19,19,19,19,19,19,19,19,19,19,19,20,20,20,20,20,20,20,20,20,20,20,20,20,20,20,20,20,20,20,21,21,21,21,21,21,21,21,21,21,21,21,21,21,21,21,21,21,21,21,21,21,21,21,21,21,22,22,22,22,22,22,22,22,22,22,22,22,22,22,22,22,22,22,22,22,22,22,22,22,22,22,22,22,22,22,0,0,0},
 {0,4,8,12,16,16,17,17,18,18,19,19,19,19,20,20,20,20,20,21,21,21,21,21,21,22,22,22,22,22,22,22,22,22,23,23,23,23,23,23,23,23,23,23,23,23,24,24,24,24,24,24,24,24,24,24,24,24,24,24,24,24,25,25,25,25,25,25,25,25,25,25,25,25,25,25,25,25,25,25,25,25,25,26,26,26,26,26,26,26,26,26,26,26,26,26,26,26,26,26,26,26,26,26,26,26,26,26,26,26,26,26,26,27,27,27,27,27,27,27,27,27,27,27,27,27,27,27,27,0,0,0},
 {0,16,18,19,20,21,21,22,22,23,23,23,24,24,24,24,25,25,25,25,25,26,26,26,26,26,26,26,26,27,27,27,27,27,27,27,27,27,27,28,28,28,28,28,28,28,28,28,28,28,28,28,29,29,29,29,29,29,29,29,29,29,29,29,29,29,29,29,29,29,30,30,30,30,30,30,30,30,30,30,30,30,30,30,30,30,30,30,30,30,30,30,30,30,30,31,31,31,31,31,31,31,31,31,31,31,31,31,31,31,31,31,31,31,31,31,31,31,31,31,31,31,31,31,31,31,31,31,31,0,0,0}};

enum { PT_PRO = 0, PT_QKV, PT_ATTN, PT_COMB, PT_WO, PT_BIN, PT_POOL, PT_BGRP, PT_BOUT, PT_CIN, PT_SGU, PT_COUT, PT_GU, PT_DOWN, PT_PGATE, PT_FINAL };
constexpr int NPHASE = 29;
__constant__ unsigned char c_prog[NPHASE][2] = {
    {PT_PRO, 0},
    {PT_QKV, 0}, {PT_ATTN, 0}, {PT_COMB, 0}, {PT_WO, 0}, {PT_GU, 0}, {PT_DOWN, 0}, {PT_PGATE, 0},
    {PT_BIN, 1}, {PT_POOL, 1}, {PT_BGRP, 1}, {PT_BOUT, 1}, {PT_GU, 1}, {PT_DOWN, 1}, {PT_PGATE, 1},
    {PT_CIN, 2}, {PT_SGU, 2}, {PT_COUT, 2}, {PT_GU, 2}, {PT_DOWN, 2}, {PT_PGATE, 2},
    {PT_QKV, 3}, {PT_ATTN, 3}, {PT_COMB, 3}, {PT_WO, 3}, {PT_GU, 3}, {PT_DOWN, 3}, {PT_PGATE, 3},
    {PT_FINAL, 0}};
__constant__ unsigned char c_hb_in[4] = {0, 1, 0, 0}, c_hb_mid[4] = {0, 1, 1, 0};

struct Args {
    const float* in[23];
    float* out; unsigned char* ws;
    int ph_lo, ph_hi;
};
enum { I_X = 0, I_P, I_REL, I_NMIX, I_NFFN, I_NPLE, I_FNORM, I_AQKV, I_AO, I_BIN, I_BGRP, I_BSCALE, I_BOUT, I_CIN, I_CVG, I_CWS, I_CBS, I_COUT, I_FG, I_FU, I_FD, I_PG, I_PP };

template <bool KS> __device__ __forceinline__ void transpose_item(const float* W, int K, int N, bf16_t* WT, int row_off, int mode, const float* kscale, LAS float* scr, int item, int lane) {
    const int nblk = N / 32, kb = item / nblk, nb = item % nblk, k0 = 64 * kb, n0 = 32 * nb;
    f32x4 v[8]; float ks[8];
#pragma unroll
    for (int j = 0; j < 8; ++j) { const int kk = 8 * j + (lane >> 3); v[j] = *(const f32x4*)(W + (size_t)(k0 + kk) * N + n0 + 4 * (lane & 7)); ks[j] = KS ? kscale[k0 + kk] : 1.0f; }
#pragma unroll
    for (int j = 0; j < 8; ++j) { const int kk = 8 * j + (lane >> 3); LAS float* d = scr + kk * 33 + 4 * (lane & 7); d[0] = v[j].x * ks[j]; d[1] = v[j].y * ks[j]; d[2] = v[j].z * ks[j]; d[3] = v[j].w * ks[j]; }
    asm volatile("s_waitcnt lgkmcnt(0)" ::: "memory");
    const int c = lane & 7;
    int drow0 = row_off + n0;
    if (mode) drow0 = (n0 >> 7) * 256 + (n0 & 127) + (mode == 2 ? 128 : 0);
#pragma unroll
    for (int j = 0; j < 4; ++j) { const int n = (lane >> 3) + 8 * j; const LAS float* s = scr + (8 * c) * 33 + n;
        u32x4 o; o.x = cvt_pk_bf16(s[0 * 33], s[1 * 33]); o.y = cvt_pk_bf16(s[2 * 33], s[3 * 33]); o.z = cvt_pk_bf16(s[4 * 33], s[5 * 33]); o.w = cvt_pk_bf16(s[6 * 33], s[7 * 33]);
        *(u32x4*)(WT + (size_t)(drow0 + n) * K + k0 + 8 * c) = o; }
    asm volatile("s_waitcnt lgkmcnt(0)" ::: "memory");
}
struct XposeCtx { LAS float* scr; int gw, NGW, lane; unsigned base; };
template <bool KS> __device__ __forceinline__ void transpose_matrix(XposeCtx& X, const float* W, int K, int N, bf16_t* WT, int row_off, int mode, const float* kscale) {
    const int nitems = (K / 64) * (N / 32);
    const int it0 = (int)(((unsigned)X.gw + (unsigned)X.NGW - X.base % (unsigned)X.NGW) % (unsigned)X.NGW);
    for (int it = it0; it < nitems; it += X.NGW) transpose_item<KS>(W, K, N, WT, row_off, mode, kscale, X.scr, it, X.lane);
    X.base += (unsigned)nitems;
}

__device__ __forceinline__ void rmsnorm_rows(const float* h, const float* g, bf16_t* outb, float* outf, int gw, int NGW, int lane) {
    f32x4 gv[4];
#pragma unroll
    for (int j = 0; j < 4; ++j) gv[j] = ((const f32x4*)g)[64 * j + lane];
    for (int m = gw; m < M; m += NGW) {
        const f32x4* xr = (const f32x4*)(h + (size_t)m * D) + lane;
        f32x4 v[4]; float s = 0.f;
#pragma unroll
        for (int j = 0; j < 4; ++j) { v[j] = xr[64 * j]; s += (v[j].x * v[j].x + v[j].y * v[j].y) + (v[j].z * v[j].z + v[j].w * v[j].w); }
        const float rstd = 1.0f / sqrtf(wave_sum(s) * (1.0f / D) + EPS);
        if (outb) { u32x2* o8 = (u32x2*)(outb + (size_t)m * D) + lane;
#pragma unroll
            for (int j = 0; j < 4; ++j) { u32x2 w; w.x = cvt_pk_bf16(v[j].x * rstd * gv[j].x, v[j].y * rstd * gv[j].y); w.y = cvt_pk_bf16(v[j].z * rstd * gv[j].z, v[j].w * rstd * gv[j].w); o8[64 * j] = w; } }
        else { f32x4* o = (f32x4*)(outf + (size_t)m * D) + lane;
#pragma unroll
            for (int j = 0; j < 4; ++j) o[64 * j] = v[j] * rstd * gv[j]; }
    }
}
__device__ __forceinline__ void final_rows(const bf16_t* hb, const float* g, float* outf, int gw, int NGW, int lane, int m_lo, int m_hi) {
    f32x4 gv[4];
#pragma unroll
    for (int j = 0; j < 4; ++j) gv[j] = ((const f32x4*)g)[64 * j + lane];
    for (int m0 = m_lo + gw; m0 < m_hi; m0 += 4 * NGW) {
        u32x2 w[4][4];
#pragma unroll
        for (int r = 0; r < 4; ++r) { const int m = m0 + r * NGW < m_hi ? m0 + r * NGW : m_hi - 1; const u32x2* xr = (const u32x2*)(hb + (size_t)m * D) + lane;
#pragma unroll
            for (int j = 0; j < 4; ++j) w[r][j] = xr[64 * j]; }
#pragma unroll
        for (int r = 0; r < 4; ++r) { const int m = m0 + r * NGW; f32x4 v[4]; float s = 0.f;
#pragma unroll
            for (int j = 0; j < 4; ++j) { v[j] = (f32x4){bf_lo(w[r][j].x), bf_hi(w[r][j].x), bf_lo(w[r][j].y), bf_hi(w[r][j].y)}; s += (v[j].x * v[j].x + v[j].y * v[j].y) + (v[j].z * v[j].z + v[j].w * v[j].w); }
            const float rstd = 1.0f / sqrtf(wave_sum(s) * (1.0f / D) + EPS);
            if (m < m_hi) { f32x4* o = (f32x4*)(outf + (size_t)m * D) + lane;
#pragma unroll
                for (int j = 0; j < 4; ++j) o[64 * j] = v[j] * rstd * gv[j]; } }
    }
}
__device__ __forceinline__ void convert_p(const float* p, bf16_t* pb, int gtid, int NT) {
    const size_t n8 = (size_t)M * PLE / 8;
    for (size_t i0 = gtid; i0 < n8; i0 += (size_t)4 * NT) {
        f32x4 a[4], b[4];
#pragma unroll
        for (int r = 0; r < 4; ++r) { const size_t i = i0 + (size_t)r * NT < n8 ? i0 + (size_t)r * NT : n8 - 1; a[r] = ((const f32x4*)p)[2 * i]; b[r] = ((const f32x4*)p)[2 * i + 1]; }
#pragma unroll
        for (int r = 0; r < 4; ++r) { const size_t i = i0 + (size_t)r * NT; if (i < n8) { u32x4 w; w.x = cvt_pk_bf16(a[r].x, a[r].y); w.y = cvt_pk_bf16(a[r].z, a[r].w); w.z = cvt_pk_bf16(b[r].x, b[r].y); w.w = cvt_pk_bf16(b[r].z, b[r].w); ((u32x4*)pb)[i] = w; } }
    }
}

constexpr int ATT_K = 0, ATT_V = 49152, ATT_LUT = 98304;
__device__ __forceinline__ int kswz(int row) { return (((row >> 1) & 3) << 1) | ((row >> 3) & 1); }
struct AttnGeom { int g, h, d, qt, N0, qcol; size_t tok0; };
__device__ __forceinline__ AttnGeom attn_geom(int unit) {
    AttnGeom a; const int idx = unit & 1023, rest = idx >> 3, b = rest >> 5, wq = rest & 31;
    a.g = unit >> 10; a.h = idx & 7; const int sh = 2 * a.g, tpp = 32 >> sh; a.d = 1 << sh;
    const int r = wq / tpp; a.qt = wq % tpp; a.N0 = a.qt * 256; a.tok0 = (size_t)b * SEQ + r; a.qcol = a.g * 512 + a.h * 64; return a;
}
__device__ __forceinline__ void attn_fetch(const bf16_t* QKV, const AttnGeom& a, int tid, u32x4 (&kr)[6], u32x4 (&vr)[6], bf16x8 (&qf)[2][2]) {
    const int lane = tid & 63, w = tid >> 6, fr = lane & 15, G = lane >> 4;
#pragma unroll
    for (int i = 0; i < 6; ++i) { const int ix = tid + 512 * i, row = ix >> 3, ch = ix & 7; int step = a.N0 - 128 + row; step = step < 0 ? 0 : step;
        const bf16_t* rp = QKV + (a.tok0 + (size_t)step * a.d) * NQKV + a.qcol + ch * 8; kr[i] = *(const u32x4*)(rp + 1536); vr[i] = *(const u32x4*)(rp + 3072); }
#pragma unroll
    for (int qi = 0; qi < 2; ++qi) { const bf16_t* qp = QKV + (a.tok0 + (size_t)(a.N0 + 32 * w + 16 * qi + fr) * a.d) * NQKV + a.qcol + 8 * G;
        qf[qi][0] = *(const bf16x8*)qp; qf[qi][1] = *(const bf16x8*)(qp + 32); }
}
__device__ __forceinline__ void attn_phase(bf16_t* QKV, float* LSE, const float* rel_table, LAS unsigned char* lds, int bx, int Gd, int tid) {
    const int lane = tid & 63, w = __builtin_amdgcn_readfirstlane(tid >> 6), fr = lane & 15, G = lane >> 4;
    {   int bk[9]; float tv[9];
#pragma unroll
        for (int k = 0; k < 9; ++k) { const int e = tid + 512 * k, gh = e / 192, rel = e - gh * 192 - 31; const int rc = rel < 0 ? 0 : (rel > 128 ? 128 : rel); bk[k] = (int)c_bucket[gh >> 3][rc] * 24 + gh; }
#pragma unroll
        for (int k = 0; k < 9; ++k) tv[k] = rel_table[bk[k]];
#pragma unroll
        for (int k = 0; k < 9; ++k) { const int e = tid + 512 * k, gh = e / 192, rel = e - gh * 192 - 31; ((LAS float*)(lds + ATT_LUT))[e] = (rel >= 0 && rel <= 128) ? tv[k] * LOG2E : -1e30f; }
    }
    u32x4 kr[6], vr[6]; bf16x8 qn[2][2];
    int unit = bx; AttnGeom a = attn_geom(unit);
    if (unit < 3072) attn_fetch(QKV, a, tid, kr, vr, qn);
    const float c1 = 0.125f * LOG2E;
    const int q4 = fr >> 2, p4 = fr & 3;
    for (; unit < 3072; unit += Gd) {
#pragma unroll
        for (int i = 0; i < 6; ++i) { const int ix = tid + 512 * i, row = ix >> 3, ch = ix & 7; const bool neg = (a.N0 - 128 + row) < 0;
            const u32x4 z = (u32x4){0u, 0u, 0u, 0u};
            *(LAS u32x4*)(lds + ATT_K + row * 128 + ((ch ^ kswz(row)) * 16)) = neg ? z : kr[i];
            *(LAS u32x4*)(lds + ATT_V + row * 128 + ((((ch >> 1) ^ ((row >> 1) & 3)) * 32) + (ch & 1) * 16)) = neg ? z : vr[i]; }
        bf16x8 qf[2][2];
#pragma unroll
        for (int qi = 0; qi < 2; ++qi) { qf[qi][0] = qn[qi][0]; qf[qi][1] = qn[qi][1]; }
        const AttnGeom c = a;
        lds_barrier();
        { const int nu = unit + Gd; if (nu < 3072) { a = attn_geom(nu); attn_fetch(QKV, a, tid, kr, vr, qn); } }
        f32x4 O[2][4]; float mrun[2], lsum[2];
#pragma unroll
        for (int qi = 0; qi < 2; ++qi) { mrun[qi] = -1e29f; lsum[qi] = 0.f;
#pragma unroll
            for (int cc = 0; cc < 4; ++cc) O[qi][cc] = (f32x4){0.f, 0.f, 0.f, 0.f}; }
        const LAS float* lut = (const LAS float*)(lds + ATT_LUT) + (c.g * 8 + c.h) * 192;
#pragma unroll 1
        for (int c5 = 0; c5 < 5; ++c5) {
            const int kbase = 32 * w + 32 * c5;
            bf16x8 kf[2][2];
#pragma unroll
            for (int kt = 0; kt < 2; ++kt) { const int row = kbase + 16 * kt + fr;
#pragma unroll
                for (int s2 = 0; s2 < 2; ++s2) kf[kt][s2] = *(const LAS bf16x8*)(lds + ATT_K + row * 128 + (((G + 4 * s2) ^ kswz(row)) * 16)); }
            bf16x8 vf[4];
#pragma unroll
            for (int cc = 0; cc < 4; ++cc) {
                const int r0 = kbase + 4 * G + q4, r1 = r0 + 16;
                const s16x4 lo = __builtin_bit_cast(s16x4, __builtin_amdgcn_ds_read_tr16_b64_v4i16((LAS s16x4*)(lds + ATT_V + r0 * 128 + ((cc ^ ((r0 >> 1) & 3)) * 32) + 8 * p4)));
                const s16x4 hi = __builtin_bit_cast(s16x4, __builtin_amdgcn_ds_read_tr16_b64_v4i16((LAS s16x4*)(lds + ATT_V + r1 * 128 + ((cc ^ ((r1 >> 1) & 3)) * 32) + 8 * p4)));
                vf[cc] = (bf16x8){lo[0], lo[1], lo[2], lo[3], hi[0], hi[1], hi[2], hi[3]}; }
            const bool edge = (c.qt == 0) && (kbase < 128);
#pragma unroll
            for (int qi = 0; qi < 2; ++qi) {
                f32x4 S[2];
#pragma unroll
                for (int kt = 0; kt < 2; ++kt) { S[kt] = __builtin_amdgcn_mfma_f32_16x16x32_bf16(kf[kt][0], qf[qi][0], (f32x4){0.f, 0.f, 0.f, 0.f}, 0, 0, 0);
                    S[kt] = __builtin_amdgcn_mfma_f32_16x16x32_bf16(kf[kt][1], qf[qi][1], S[kt], 0, 0, 0); }
                float mx = -1e30f;
#pragma unroll
                for (int kt = 0; kt < 2; ++kt)
#pragma unroll
                    for (int i = 0; i < 4; ++i) { const int li = 159 + 16 * qi + fr - 4 * G - 32 * c5 - 16 * kt - i;
                        float sv = S[kt][i] * c1 + lut[li];
                        if (edge && (kbase + 16 * kt + 4 * G + i) < 128) sv = -1e30f;
                        S[kt][i] = sv; mx = fmaxf(mx, sv); }
                mx = fmaxf(mx, __shfl_xor(mx, 16)); mx = fmaxf(mx, __shfl_xor(mx, 32));
                const float mnew = fmaxf(mrun[qi], mx), alpha = fast_exp2(mrun[qi] - mnew); mrun[qi] = mnew;
                float ps = 0.f;
#pragma unroll
                for (int kt = 0; kt < 2; ++kt)
#pragma unroll
                    for (int i = 0; i < 4; ++i) { const float p = fast_exp2(S[kt][i] - mnew); S[kt][i] = p; ps += p; }
                lsum[qi] = lsum[qi] * alpha + ps;
                u32x4 pw; pw.x = cvt_pk_bf16(S[0][0], S[0][1]); pw.y = cvt_pk_bf16(S[0][2], S[0][3]); pw.z = cvt_pk_bf16(S[1][0], S[1][1]); pw.w = cvt_pk_bf16(S[1][2], S[1][3]);
                const bf16x8 pf = __builtin_bit_cast(bf16x8, pw);
#pragma unroll
                for (int cc = 0; cc < 4; ++cc) { O[qi][cc] = O[qi][cc] * alpha; O[qi][cc] = __builtin_amdgcn_mfma_f32_16x16x32_bf16(vf[cc], pf, O[qi][cc], 0, 0, 0); }
            }
        }
#pragma unroll
        for (int qi = 0; qi < 2; ++qi) {
            float l = lsum[qi]; l += __shfl_xor(l, 16); l += __shfl_xor(l, 32);
            const float inv = 1.0f / l;
            const size_t tok = c.tok0 + (size_t)(c.N0 + 32 * w + 16 * qi + fr) * c.d;
            bf16_t* op = QKV + tok * NQKV + c.qcol + 4 * G;
#pragma unroll
            for (int cc = 0; cc < 4; ++cc) { u32x2 o; o.x = cvt_pk_bf16(O[qi][cc][0] * inv, O[qi][cc][1] * inv); o.y = cvt_pk_bf16(O[qi][cc][2] * inv, O[qi][cc][3] * inv); *(u32x2*)(op + 16 * cc) = o; }
            if (G == 0) LSE[(tok * 3 + c.g) * 8 + c.h] = mrun[qi] + __log2f(l);
        }
        lds_barrier();
    }
}
__device__ __forceinline__ void attn_combine(bf16_t* QKV, const float* LSE, int gtid, int NT, int ix_lo, int ix_hi) {
    for (int ix0 = ix_lo + gtid; ix0 < ix_hi; ix0 += 4 * NT) {
        float l[4][3]; u32x4 a[4][3];
#pragma unroll
        for (int r = 0; r < 4; ++r) { const int ix = ix0 + r * NT < ix_hi ? ix0 + r * NT : ix_hi - 1; const int tok = ix >> 6, h = (ix >> 3) & 7, ch = ix & 7;
            const bf16_t* qp = QKV + (size_t)tok * NQKV + h * 64 + ch * 8;
#pragma unroll
            for (int g = 0; g < 3; ++g) { l[r][g] = LSE[((size_t)tok * 3 + g) * 8 + h]; a[r][g] = *(const u32x4*)(qp + 512 * g); } }
#pragma unroll
        for (int r = 0; r < 4; ++r) { const int ix = ix0 + r * NT; const int tok = ix >> 6, h = (ix >> 3) & 7, ch = ix & 7;
            const float mx = fmaxf(l[r][0], fmaxf(l[r][1], l[r][2])); float w0 = fast_exp2(l[r][0] - mx), w1 = fast_exp2(l[r][1] - mx), w2 = fast_exp2(l[r][2] - mx); const float inv = 1.0f / (w0 + w1 + w2); w0 *= inv; w1 *= inv; w2 *= inv;
            u32x4 o;
#pragma unroll
            for (int j = 0; j < 4; ++j) { const float lo = w0 * bf_lo(a[r][0][j]) + w1 * bf_lo(a[r][1][j]) + w2 * bf_lo(a[r][2][j]), hi = w0 * bf_hi(a[r][0][j]) + w1 * bf_hi(a[r][1][j]) + w2 * bf_hi(a[r][2][j]); o[j] = cvt_pk_bf16(lo, hi); }
            if (ix < ix_hi) *(u32x4*)(QKV + (size_t)tok * NQKV + 1536 + h * 64 + ch * 8) = o; }
    }
}

template <int WIN> __device__ __forceinline__ void pool_strip(const bf16_t* Y, bf16_t* Z, int t0, int col) {
    const int spos0 = t0 & (SEQ - 1);
    u32x4 r[WIN + 7];
#pragma unroll
    for (int i = 0; i < WIN + 7; ++i) { const int rel = i - (WIN - 1); const bool ok = spos0 + rel >= 0; const int tok = ok ? t0 + rel : t0;
        r[i] = *(const u32x4*)(Y + (size_t)tok * D + col); if (!ok) r[i] = (u32x4){0u, 0u, 0u, 0u}; }
    float S[8];
#pragma unroll
    for (int c = 0; c < 8; ++c) S[c] = 0.f;
#pragma unroll
    for (int i = 0; i < WIN - 1; ++i)
#pragma unroll
        for (int c = 0; c < 4; ++c) { S[2 * c] += bf_lo(r[i][c]); S[2 * c + 1] += bf_hi(r[i][c]); }
#pragma unroll
    for (int j = 0; j < 8; ++j) { const u32x4 y = r[WIN - 1 + j];
#pragma unroll
        for (int c = 0; c < 4; ++c) { S[2 * c] += bf_lo(y[c]); S[2 * c + 1] += bf_hi(y[c]); }
        const int n = (spos0 + j + 1) < WIN ? (spos0 + j + 1) : WIN; const float inv = 1.0f / (float)n; u32x4 o;
#pragma unroll
        for (int c = 0; c < 4; ++c) o[c] = cvt_pk_bf16(S[2 * c] * inv - bf_lo(y[c]), S[2 * c + 1] * inv - bf_hi(y[c]));
        *(u32x4*)(Z + (size_t)(t0 + j) * D + col) = o;
        const u32x4 q = r[j];
#pragma unroll
        for (int c = 0; c < 4; ++c) { S[2 * c] -= bf_lo(q[c]); S[2 * c + 1] -= bf_hi(q[c]); } }
}
__device__ __forceinline__ void pool_phase(const bf16_t* Y, bf16_t* Z, int gw, int NGW, int lane, int it_lo, int it_hi) {
    for (int it = it_lo + gw; it < it_hi; it += NGW) { const int g = it & 3, sp = it >> 2; const int t0 = (sp * 2 + (lane >> 5)) * 8, col = g * 256 + (lane & 31) * 8;
        if (g == 0) pool_strip<2>(Y, Z, t0, col); else if (g == 1) pool_strip<4>(Y, Z, t0, col); else if (g == 2) pool_strip<8>(Y, Z, t0, col); else pool_strip<16>(Y, Z, t0, col); }
}

constexpr int SG_VN = 0, SG_WM = 65536, SG_ST = 98304;
__device__ __forceinline__ void sgu_unit(const bf16_t* Zc, bf16_t* Gt, const float* vgain, const float* w_s, const float* b_s, LAS unsigned char* lds, int chunk, int tid) {
    const int lane = tid & 63, w = __builtin_amdgcn_readfirstlane(tid >> 6), fr = lane & 15, G = lane >> 4;
    const size_t t0 = (size_t)chunk * 128;
    LAS float* st = (LAS float*)(lds + SG_ST);
    for (int i0 = 0; i0 < 16; i0 += 4) {
        u32x4 a[4], b2[4];
#pragma unroll
        for (int r = 0; r < 4; ++r) { const u32x4* vp = (const u32x4*)(Zc + (t0 + 16 * w + i0 + r) * 2048 + 1024) + lane; a[r] = vp[0]; b2[r] = vp[64]; }
#pragma unroll
        for (int r = 0; r < 4; ++r) { const int t = 16 * w + i0 + r; float x[16];
#pragma unroll
            for (int j = 0; j < 4; ++j) { x[2 * j] = bf_lo(a[r][j]); x[2 * j + 1] = bf_hi(a[r][j]); x[8 + 2 * j] = bf_lo(b2[r][j]); x[9 + 2 * j] = bf_hi(b2[r][j]); }
            float sm = 0.f;
#pragma unroll
            for (int j = 0; j < 16; ++j) sm += x[j];
            const float mu = wave_sum(sm) * (1.0f / 1024.0f); float q = 0.f;
#pragma unroll
            for (int j = 0; j < 16; ++j) { const float dd = x[j] - mu; q += dd * dd; }
            const float rstd = 1.0f / sqrtf(wave_sum(q) * (1.0f / 1024.0f) + EPS);
            if (lane == 0) { st[2 * t] = mu; st[2 * t + 1] = rstd; } }
    }
    lds_barrier();
    for (int g = 0; g < 4; ++g) {
#pragma unroll
        for (int i = 0; i < 8; ++i) { const int ix = tid + 512 * i, s = ix >> 5, ch = ix & 31, c0 = g * 256 + ch * 8;
            const u32x4 a = *(const u32x4*)(Zc + (t0 + s) * 2048 + 1024 + c0); const f32x4 g0 = *(const f32x4*)(vgain + c0), g1 = *(const f32x4*)(vgain + c0 + 4);
            const float mu = st[2 * s], rs = st[2 * s + 1]; u32x4 o;
            o.x = cvt_pk_bf16((bf_lo(a.x) - mu) * rs * g0.x, (bf_hi(a.x) - mu) * rs * g0.y); o.y = cvt_pk_bf16((bf_lo(a.y) - mu) * rs * g0.z, (bf_hi(a.y) - mu) * rs * g0.w);
            o.z = cvt_pk_bf16((bf_lo(a.z) - mu) * rs * g1.x, (bf_hi(a.z) - mu) * rs * g1.y); o.w = cvt_pk_bf16((bf_lo(a.w) - mu) * rs * g1.z, (bf_hi(a.w) - mu) * rs * g1.w);
            const int sw = (s & 3) | (((s >> 3) & 1) << 2);
            *(LAS u32x4*)(lds + SG_VN + s * 512 + ((((ch >> 1) ^ sw)) * 32) + (ch & 1) * 16) = o; }
#pragma unroll
        for (int i = 0; i < 4; ++i) { const int ix = tid + 512 * i, t = ix >> 4, ch = ix & 15, s0 = ch * 8;
            const float* wp = w_s + ((size_t)g * 128 + t) * 128 + s0; const f32x4 a = *(const f32x4*)wp, b2 = *(const f32x4*)(wp + 4); float x[8] = {a.x, a.y, a.z, a.w, b2.x, b2.y, b2.z, b2.w};
#pragma unroll
            for (int j = 0; j < 8; ++j) if (s0 + j > t) x[j] = 0.f;
            u32x4 o; o.x = cvt_pk_bf16(x[0], x[1]); o.y = cvt_pk_bf16(x[2], x[3]); o.z = cvt_pk_bf16(x[4], x[5]); o.w = cvt_pk_bf16(x[6], x[7]);
            *(LAS u32x4*)(lds + SG_WM + t * 256 + ((ch ^ (t & 15)) * 16)) = o; }
        lds_barrier();
        f32x4 acc[2][8];
#pragma unroll
        for (int ct = 0; ct < 2; ++ct)
#pragma unroll
            for (int tt = 0; tt < 8; ++tt) acc[ct][tt] = (f32x4){0.f, 0.f, 0.f, 0.f};
        const int q4 = fr >> 2, p4 = fr & 3;
#pragma unroll
        for (int sc = 0; sc < 4; ++sc) {
            bf16x8 af[2];
#pragma unroll
            for (int ct = 0; ct < 2; ++ct) { const int r0 = 32 * sc + 8 * G + q4, r1 = r0 + 4, u32 = 2 * w + ct;
                const int sw0 = (r0 & 3) | (((r0 >> 3) & 1) << 2), sw1 = (r1 & 3) | (((r1 >> 3) & 1) << 2);
                const s16x4 lo = __builtin_bit_cast(s16x4, __builtin_amdgcn_ds_read_tr16_b64_v4i16((LAS s16x4*)(lds + SG_VN + r0 * 512 + ((u32 ^ sw0) * 32) + 8 * p4)));
                const s16x4 hi = __builtin_bit_cast(s16x4, __builtin_amdgcn_ds_read_tr16_b64_v4i16((LAS s16x4*)(lds + SG_VN + r1 * 512 + ((u32 ^ sw1) * 32) + 8 * p4)));
                af[ct] = (bf16x8){lo[0], lo[1], lo[2], lo[3], hi[0], hi[1], hi[2], hi[3]}; }
#pragma unroll
            for (int tt = 0; tt < 8; ++tt) { const int t = 16 * tt + fr; const bf16x8 bfr = *(const LAS bf16x8*)(lds + SG_WM + t * 256 + (((4 * sc + G) ^ (t & 15)) * 16));
#pragma unroll
                for (int ct = 0; ct < 2; ++ct) acc[ct][tt] = __builtin_amdgcn_mfma_f32_16x16x32_bf16(af[ct], bfr, acc[ct][tt], 0, 0, 0); }
        }
#pragma unroll
        for (int tt = 0; tt < 8; ++tt) { const int t = 16 * tt + fr; const float bs = b_s[g * 128 + t];
#pragma unroll
            for (int ct = 0; ct < 2; ++ct) { const int c = g * 256 + 32 * w + 16 * ct + 4 * G; const u32x2 uu = *(const u32x2*)(Zc + (t0 + t) * 2048 + c);
                u32x2 o; o.x = cvt_pk_bf16(bf_lo(uu.x) * (acc[ct][tt][0] + bs), bf_hi(uu.x) * (acc[ct][tt][1] + bs)); o.y = cvt_pk_bf16(bf_lo(uu.y) * (acc[ct][tt][2] + bs), bf_hi(uu.y) * (acc[ct][tt][3] + bs));
                *(u32x2*)(Gt + (t0 + t) * 1024 + c) = o; } }
        lds_barrier();
    }
}

#define XB_TMO      128
#define XB_XCNT(j)  (256  + 64 * (j))
#define XB_XSUB(j)  (1280 + 64 * (j))
#define XB_XGEN(j)  (2304 + 64 * (j))
#define XB_TOP      3328
#define XB_TOPGEN   3392
#define XCD_BAR_WORDS 3456
#define XB_SPIN_CAP (1u << 18)

__device__ __forceinline__ unsigned xb_ld(unsigned* p)              { return __hip_atomic_load(p, __ATOMIC_RELAXED, __HIP_MEMORY_SCOPE_AGENT); }
__device__ __forceinline__ unsigned xb_add(unsigned* p, unsigned v) { return __hip_atomic_fetch_add(p, v, __ATOMIC_RELAXED, __HIP_MEMORY_SCOPE_AGENT); }
__device__ __forceinline__ unsigned xb_xcc_id() { return (unsigned)__builtin_amdgcn_s_getreg((3 << 11) | 20) & 0xFu; }
#define XB_SPIN(cond, bar) do { unsigned _sp = 0; while (cond) { __builtin_amdgcn_s_sleep(1); \
    if ((++_sp & 255u) == 0u) { if (xb_ld(&(bar)[XB_TMO])) break; if (_sp > XB_SPIN_CAP) { atomicAdd(&(bar)[XB_TMO], 1u); break; } } } } while (0)

struct XcdBarrier {
    unsigned* bar; unsigned x;
    volatile LAS unsigned* st;
};

__device__ __forceinline__ XcdBarrier xcd_barrier_post(unsigned* bar, volatile LAS unsigned* st) {
    XcdBarrier b; b.bar = bar; b.x = xb_xcc_id(); b.st = st;
    if (threadIdx.x == 0) st[2] = xb_add(&bar[XB_XCNT(b.x)], 1u);
    return b;
}
__device__ __forceinline__ void xcd_barrier_complete(unsigned* bar, unsigned x, unsigned& nloc, unsigned& nx) {
    const unsigned G = gridDim.x * gridDim.y * gridDim.z;
    unsigned sum, cnt, mine, sp = 0u;
    for (;;) {
        sum = 0u; cnt = 0u; mine = 0u;
#pragma unroll
        for (unsigned j = 0; j < 16; ++j) { const unsigned c = xb_ld(&bar[XB_XCNT(j)]); sum += c; cnt += (c > 0u) ? 1u : 0u; mine = (j == x) ? c : mine; }
        if (sum == G) break;
        __builtin_amdgcn_s_sleep(1);
        if ((++sp & 255u) == 0u) { if (xb_ld(&bar[XB_TMO])) break; if (sp > XB_SPIN_CAP) { atomicAdd(&bar[XB_TMO], 1u); break; } }
    }
    nloc = mine > 0u ? mine : 1u; nx = cnt > 0u ? cnt : 1u;
}
__device__ __forceinline__ unsigned xcd_census_uniform(unsigned* bar, unsigned nloc) {
    unsigned ok = 1u;
#pragma unroll
    for (unsigned j = 0; j < 16; ++j) { const unsigned c = xb_ld(&bar[XB_XCNT(j)]); if (c != (j < 8u ? nloc : 0u)) ok = 0u; }
    return ok;
}
#define XB_LSUB(j)  (4096 + 64 * (j))
#define XB_LGEN(j)  (5120 + 64 * (j))
#define XB_ALL_WORDS 6144
__device__ __forceinline__ void xcd_local_barrier(const XcdBarrier& b) {
    asm volatile("s_waitcnt vmcnt(0)" ::: "memory");
    __syncthreads();
    if (threadIdx.x == 0) {
        unsigned* bar = b.bar; const unsigned nloc = b.st[0];
        const unsigned old = xb_add(&bar[XB_LSUB(b.x)], 1u), gen = old / nloc;
        if (old + 1u == (gen + 1u) * nloc) xb_add(&bar[XB_LGEN(b.x)], 1u);
        else XB_SPIN(xb_ld(&bar[XB_LGEN(b.x)]) == gen, bar);
        __builtin_amdgcn_fence(__ATOMIC_ACQUIRE, "agent");
        asm volatile("s_waitcnt vmcnt(0)" ::: "memory");
    }
    __syncthreads();
}

__device__ __forceinline__ void xcd_barrier(const XcdBarrier& b) {
    asm volatile("s_waitcnt vmcnt(0)" ::: "memory");
    __syncthreads();
    if (threadIdx.x == 0) {
        unsigned* bar = b.bar;
        __builtin_amdgcn_s_waitcnt(0);
        unsigned nloc = b.st[0], nx = b.st[1];
        if (nloc == 0u) { xcd_barrier_complete(bar, b.x, nloc, nx); b.st[0] = nloc; b.st[1] = nx; b.st[3] = xcd_census_uniform(bar, nloc); }
        const unsigned old = xb_add(&bar[XB_XSUB(b.x)], 1u);
        const unsigned gen = old / nloc;
        if (old + 1u == (gen + 1u) * nloc) {
            __builtin_amdgcn_fence(__ATOMIC_RELEASE, "agent");
            asm volatile("s_waitcnt vmcnt(0)" ::: "memory");
            const unsigned og = xb_add(&bar[XB_TOP], 1u);
            const unsigned tg = og / nx;
            if (og + 1u == (tg + 1u) * nx) xb_add(&bar[XB_TOPGEN], 1u);
            else XB_SPIN(xb_ld(&bar[XB_TOPGEN]) == tg, bar);
            __builtin_amdgcn_fence(__ATOMIC_ACQUIRE, "agent");
            xb_add(&bar[XB_XGEN(b.x)], 1u);
            asm volatile("s_waitcnt vmcnt(0)" ::: "memory");
        } else {
            XB_SPIN(xb_ld(&bar[XB_XGEN(b.x)]) == gen, bar);
            __builtin_amdgcn_fence(__ATOMIC_ACQUIRE, "agent");
            asm volatile("s_waitcnt vmcnt(0)" ::: "memory");
        }
    }
    __syncthreads();
}

__device__ __forceinline__ void x_rows(const float* x, bf16_t* xb, pg8::ssq_t* ssq, int gw, int NGW, int lane) {
    for (int m0 = gw; m0 < M; m0 += 4 * NGW) {
        f32x4 v[4][4];
#pragma unroll
        for (int r = 0; r < 4; ++r) { const int m = m0 + r * NGW < M ? m0 + r * NGW : M - 1; const f32x4* xr = (const f32x4*)(x + (size_t)m * D) + lane;
#pragma unroll
            for (int j = 0; j < 4; ++j) v[r][j] = xr[64 * j]; }
#pragma unroll
        for (int r = 0; r < 4; ++r) { const int m = m0 + r * NGW; float s = 0.f;
#pragma unroll
            for (int j = 0; j < 4; ++j) s += (v[r][j].x * v[r][j].x + v[r][j].y * v[r][j].y) + (v[r][j].z * v[r][j].z + v[r][j].w * v[r][j].w);
            s = wave_sum(s);
            if (m < M) { u32x2* o8 = (u32x2*)(xb + (size_t)m * D) + lane;
#pragma unroll
                for (int j = 0; j < 4; ++j) { u32x2 w; w.x = cvt_pk_bf16(v[r][j].x, v[r][j].y); w.y = cvt_pk_bf16(v[r][j].z, v[r][j].w); o8[64 * j] = w; }
                if (lane == 0) ssq[m] = (pg8::ssq_t)(s * pg8::SSQ_SCALE); } }
    }
}

__global__ void __launch_bounds__(512, 2) fwd_kernel(Args args) {
    extern __shared__ __attribute__((aligned(16))) unsigned char lds_raw[];
    LAS unsigned char* lds = (LAS unsigned char*)lds_raw;
    if (threadIdx.x < 16) ((LAS unsigned*)(lds + 131072))[threadIdx.x] = 0u;
    __syncthreads();
    XcdBarrier xbar; xbar.bar = (unsigned*)(args.ws + WS_BAR); xbar.x = 0; xbar.st = (volatile LAS unsigned*)(lds + 131072);
    for (int ph = args.ph_lo; ph < args.ph_hi; ++ph) {
        const __attribute__((address_space(4))) Args* ap = (const __attribute__((address_space(4))) Args*)__builtin_amdgcn_kernarg_segment_ptr(); asm volatile("" : "+s"(ap));
        int tid = threadIdx.x; asm volatile("" : "+v"(tid));
        const int lane = tid & 63, wave = __builtin_amdgcn_readfirstlane(tid >> 6);
        int Gd = gridDim.x, bx = blockIdx.x; asm volatile("" : "+s"(Gd), "+s"(bx));
        const int gw = bx * 8 + wave, NGW = Gd * 8, gtid = bx * 512 + tid, NT = Gd * 512;
        unsigned char* ws = ap->ws; asm volatile("" : "+s"(ws)); ws = as_global(ws);
        bf16_t* PBF = (bf16_t*)(ws + WS_PBF); float* LSE = (float*)(ws + WS_LSE); bf16_t* BIG = (bf16_t*)(ws + WS_BIG);
        pg8::ssq_t* SSQ = (pg8::ssq_t*)(ws + WS_SSQ);
        float* H = as_global(ap->out);
        const int type = c_prog[ph][0], layer = c_prog[ph][1];
        int zoff = 0; asm volatile("" : "+v"(zoff));
        const volatile LAS unsigned* stw = (const volatile LAS unsigned*)(lds + 131072 + zoff);
        const bool uni = __builtin_amdgcn_readfirstlane((int)stw[3]) != 0 && Gd == 256;
        const int xrank = __builtin_amdgcn_readfirstlane((int)stw[2]), xcc = (int)xbar.x;
        bf16_t* HBin = (bf16_t*)(ws + (c_hb_in[layer] ? WS_X1 : WS_X0)); bf16_t* HBmid = (bf16_t*)(ws + (c_hb_mid[layer] ? WS_X1 : WS_X0)); bf16_t* HBoth = (bf16_t*)(ws + (c_hb_mid[layer] ? WS_X0 : WS_X1));
        pg8::Gemm gm{nullptr, nullptr, M, 0, 0, 0, 0, 0}; int epi = -1; bf16_t* ob = nullptr; int ldc = 0; const pg8::ssq_t* ssq_in = SSQ + (size_t)13 * M; pg8::ssq_t* ssq_out = nullptr; bf16_t* hbo = nullptr; const bf16_t* hbase = nullptr;
        bool second = false; bool conv_p = false;
        switch (type) {
#ifndef DIS_PRO
        case PT_PRO: {
            if (bx == 0 && ph == 0) for (int i = tid; i < XB_ALL_WORDS; i += 512) ((unsigned*)(ws + WS_BAR))[i] = 0u;
            unsigned cz = 0u, co = 1073740750u; asm volatile("" : "+v"(cz), "+v"(co));
            for (int i = gtid; i < 12 * M / 2; i += NT) ((u32x4*)(SSQ + M))[i] = (u32x4){cz, cz, cz, cz};
            for (int i = gtid; i < M / 2; i += NT) ((u32x4*)(SSQ + (size_t)13 * M))[i] = (u32x4){co, cz, co, cz};
            XposeCtx X{(LAS float*)(lds + wave * 16384), gw, NGW, lane, 0u};
            for (int j = 0; j < 2; ++j) {
                transpose_matrix<true>(X, as_global(ap->in[I_AQKV]) + (size_t)j * D * NQKV, D, NQKV, (bf16_t*)(ws + WS_WQKV) + (size_t)j * NQKV * D, 0, 0, as_global(ap->in[I_NMIX]) + (j ? 3 : 0) * D);
                transpose_matrix<false>(X, as_global(ap->in[I_AO]) + (size_t)j * 512 * D, 512, D, (bf16_t*)(ws + WS_WO) + (size_t)j * D * 512, 0, 0, nullptr);
            }
            transpose_matrix<true>(X, as_global(ap->in[I_BIN]), D, D, (bf16_t*)(ws + WS_BIN), 0, 0, as_global(ap->in[I_NMIX]) + 1 * D);
            for (int g = 0; g < 4; ++g) transpose_matrix<false>(X, as_global(ap->in[I_BGRP]) + (size_t)g * 65536, 256, 256, (bf16_t*)(ws + WS_BGRP), g * 256, 0, nullptr);
            transpose_matrix<true>(X, as_global(ap->in[I_BOUT]), D, D, (bf16_t*)(ws + WS_BOUT), 0, 0, as_global(ap->in[I_BSCALE]));
            transpose_matrix<true>(X, as_global(ap->in[I_CIN]), D, 2048, (bf16_t*)(ws + WS_CIN), 0, 0, as_global(ap->in[I_NMIX]) + 2 * D);
            transpose_matrix<false>(X, as_global(ap->in[I_COUT]), D, D, (bf16_t*)(ws + WS_COUT), 0, 0, nullptr);
            for (int i = 0; i < DEPTH; ++i) {
                transpose_matrix<true>(X, as_global(ap->in[I_FG]) + (size_t)i * D * FF, D, FF, (bf16_t*)(ws + WS_WGU) + (size_t)i * 2 * FF * D, 0, 1, as_global(ap->in[I_NFFN]) + i * D);
                transpose_matrix<true>(X, as_global(ap->in[I_FU]) + (size_t)i * D * FF, D, FF, (bf16_t*)(ws + WS_WGU) + (size_t)i * 2 * FF * D, 0, 2, as_global(ap->in[I_NFFN]) + i * D);
                transpose_matrix<false>(X, as_global(ap->in[I_FD]) + (size_t)i * FF * D, FF, D, (bf16_t*)(ws + WS_WDN) + (size_t)i * D * FF, 0, 0, nullptr);
                transpose_matrix<true>(X, as_global(ap->in[I_PG]) + (size_t)i * D * D, D, D, (bf16_t*)(ws + WS_WPG) + (size_t)i * D * D, 0, 0, as_global(ap->in[I_NPLE]) + i * D);
                transpose_matrix<false>(X, as_global(ap->in[I_PP]) + (size_t)i * PLE * D, PLE, D, (bf16_t*)(ws + WS_WPP) + (size_t)i * D * PLE, 0, 0, nullptr);
            }
            x_rows(as_global(ap->in[I_X]), (bf16_t*)(ws + WS_X0), SSQ, gw, NGW, lane);
            convert_p(as_global(ap->in[I_P]), PBF, gtid, NT);
        } break;
#endif
        case PT_FINAL: final_rows((const bf16_t*)(ws + WS_X1), as_global(ap->in[I_FNORM]), H, uni ? xrank * 8 + wave : gw, uni ? 256 : NGW, lane, uni ? xcc * 4096 : 0, uni ? (xcc + 1) * 4096 : M); break;
        case PT_QKV: gm.A = HBin; gm.Bt = (bf16_t*)(ws + WS_WQKV) + (size_t)(layer / 3) * NQKV * D; gm.N = NQKV; gm.K = D; gm.lda = D; gm.ldb = D; epi = 0; ob = BIG; ldc = NQKV; ssq_in = SSQ + (size_t)(3 * layer) * M; conv_p = layer > 0; break;
#ifndef DIS_ATTN
        case PT_ATTN: attn_phase(BIG, LSE, as_global(ap->in[I_REL]), lds, bx, Gd, tid); break;
#endif
        case PT_COMB: attn_combine(BIG, LSE, uni ? xrank * 512 + tid : gtid, uni ? 32 * 512 : NT, uni ? xcc * (M * 8) : 0, uni ? (xcc + 1) * (M * 8) : M * 64); break;
        case PT_WO: gm.A = BIG + 1536; gm.Bt = (bf16_t*)(ws + WS_WO) + (size_t)(layer / 3) * D * 512; gm.N = D; gm.K = 512; gm.lda = NQKV; gm.ldb = 512; epi = 3; hbo = HBmid; ssq_out = SSQ + (size_t)(3 * layer + 1) * M; hbase = HBin; break;
        case PT_BIN: gm.A = HBin; gm.Bt = (bf16_t*)(ws + WS_BIN); gm.N = D; gm.K = D; gm.lda = D; gm.ldb = D; epi = 0; ob = BIG; ldc = D; ssq_in = SSQ + (size_t)(3 * layer) * M; conv_p = true; break;
        case PT_POOL: pool_phase(BIG, BIG + (size_t)M * D, uni ? xrank * 8 + wave : gw, uni ? 256 : NGW, lane, uni ? xcc * 1024 : 0, uni ? (xcc + 1) * 1024 : (M / 16) * 4); break;
        case PT_BGRP: gm.A = BIG + (size_t)M * D; gm.Bt = (bf16_t*)(ws + WS_BGRP); gm.N = D; gm.K = 256; gm.lda = D; gm.ldb = 256; gm.apn = 256; epi = 0; ob = BIG + (size_t)2 * M * D; ldc = D; break;
        case PT_BOUT: gm.A = BIG + (size_t)2 * M * D; gm.Bt = (bf16_t*)(ws + WS_BOUT); gm.N = D; gm.K = D; gm.lda = D; gm.ldb = D; epi = 3; hbo = HBmid; ssq_out = SSQ + (size_t)(3 * layer + 1) * M; hbase = HBin; break;
        case PT_CIN: gm.A = HBin; gm.Bt = (bf16_t*)(ws + WS_CIN); gm.N = 2048; gm.K = D; gm.lda = D; gm.ldb = D; epi = 1; ob = BIG; ldc = 2048; ssq_in = SSQ + (size_t)(3 * layer) * M; conv_p = true; break;
#ifndef DIS_SGU
        case PT_SGU: for (int u = uni ? xcc * 32 + xrank : bx; u < M / 128; u += Gd) sgu_unit(BIG, BIG + (size_t)M * 2048, as_global(ap->in[I_CVG]), as_global(ap->in[I_CWS]), as_global(ap->in[I_CBS]), lds, u, tid); break;
#endif
        case PT_COUT: gm.A = BIG + (size_t)M * 2048; gm.Bt = (bf16_t*)(ws + WS_COUT); gm.N = D; gm.K = D; gm.lda = D; gm.ldb = D; epi = 3; hbo = HBmid; ssq_out = SSQ + (size_t)(3 * layer + 1) * M; hbase = HBin; break;
        case PT_GU: gm.A = HBmid; gm.Bt = (bf16_t*)(ws + WS_WGU) + (size_t)layer * 2 * FF * D; gm.N = 2 * FF; gm.K = D; gm.lda = D; gm.ldb = D; epi = 2; ob = BIG; ldc = FF; ssq_in = SSQ + (size_t)(3 * layer + 1) * M; break;
        case PT_DOWN: gm.A = BIG; gm.Bt = (bf16_t*)(ws + WS_WDN) + (size_t)layer * D * FF; gm.N = D; gm.K = FF; gm.lda = FF; gm.ldb = FF; epi = 3; hbo = HBmid; ssq_out = SSQ + (size_t)(3 * layer + 2) * M; second = true; hbase = HBmid; break;
        case PT_PGATE: gm.A = HBmid; gm.Bt = (bf16_t*)(ws + WS_WPG) + (size_t)layer * D * D; gm.N = D; gm.K = D; gm.lda = D; gm.ldb = D; epi = 4; ssq_in = SSQ + (size_t)(3 * layer + 2) * M; ssq_out = SSQ + (size_t)(3 * layer + 3) * M; break;
        default: break;
        }
#ifndef DIS_GEMM
        if (epi >= 0) {
            int cv = bx;
            if (uni) cv = xrank * 8 + xcc;
            pg8::StaticOrder S; S.init(M, gm.N, Gd, cv);
#ifdef ONLY_EPI
            if (epi != ONLY_EPI) epi = 99;
#endif
            if (epi == 99) {} else
            if (epi == 0) { pg8::EpiBf16<0> E{ob, ldc, ssq_in}; pg8::gemm_phase<pg8::EpiBf16<0>, true>(lds, gm, S, E, tid); }
            else if (epi == 1) { pg8::EpiBf16<1> E{ob, ldc, ssq_in}; pg8::gemm_phase<pg8::EpiBf16<1>, true>(lds, gm, S, E, tid); }
            else if (epi == 2) { pg8::EpiSwiGLU E{ob, ldc, ssq_in}; pg8::gemm_phase<pg8::EpiSwiGLU, true>(lds, gm, S, E, tid); }
            else if (epi == 3) { pg8::EpiRes E{hbase, hbo, ssq_out}; pg8::gemm_phase<pg8::EpiRes, false>(lds, gm, S, E, tid); }
            else { pg8::EpiPle E{HBmid, HBoth, ssq_in, ssq_out}; pg8::gemm_phase<pg8::EpiPle, false>(lds, gm, S, E, tid); }
        }
        if (second) {
            pg8::Gemm g2{PBF, (bf16_t*)(ws + WS_WPP) + (size_t)layer * D * PLE, M, D, PLE, PLE, PLE, 0};
            const int cv = uni ? xrank * 8 + xcc : bx;
            pg8::StaticOrder S; S.init(M, D, Gd, cv);
            pg8::EpiBf16<0> E{HBoth, D, SSQ + (size_t)13 * M}; pg8::gemm_phase<pg8::EpiBf16<0>, true>(lds, g2, S, E, tid);
        }
#endif
        if (conv_p) convert_p(as_global(ap->in[I_P]) + (size_t)layer * M * PLE, PBF, gtid, NT);
        if (ph + 1 < args.ph_hi) {
            if (ph == 0) { cg::this_grid().sync(); xbar = xcd_barrier_post((unsigned*)(args.ws + WS_BAR), (volatile LAS unsigned*)(lds + 131072)); }
            else {
                const bool loc = uni && (type == PT_GU || type == PT_DOWN || type == PT_COMB || type == PT_POOL || type == PT_BGRP || type == PT_CIN || type == PT_SGU || (type == PT_PGATE && layer == 3));
                if (loc) xcd_local_barrier(xbar); else xcd_barrier(xbar);
            }
        }
    }
}

extern "C" void kernel_launch(void* const* d_in, const int* in_sizes, int n_in, void* d_out, int out_size, void* d_ws, size_t ws_size, hipStream_t stream) {
    static int grid = 0;
    if (grid == 0) {
        if (n_in != 23 || out_size != M * D || ws_size < WS_END) { fprintf(stderr, "kernel_launch: unexpected problem (n_in %d, out %d, ws %zu < %zu)\n", n_in, out_size, ws_size, (size_t)WS_END); grid = -1; return; }
        int dev = 0, cus = 0, per_cu = 0;
        hipGetDevice(&dev); hipDeviceGetAttribute(&cus, hipDeviceAttributeMultiprocessorCount, dev);
        if (hipFuncSetAttribute((const void*)fwd_kernel, hipFuncAttributeMaxDynamicSharedMemorySize, LDS_BYTES) != hipSuccess) { fprintf(stderr, "kernel_launch: hipFuncSetAttribute failed\n"); grid = -1; return; }
        if (hipOccupancyMaxActiveBlocksPerMultiprocessor(&per_cu, (const void*)fwd_kernel, 512, LDS_BYTES) != hipSuccess || per_cu < 1) { fprintf(stderr, "kernel_launch: occupancy query says %d blocks/CU\n", per_cu); per_cu = 1; }
        (void)hipGetLastError();
        grid = cus;
    }
    if (grid < 0) return;
    Args a{};
    for (int i = 0; i < 23; ++i) a.in[i] = (const float*)d_in[i];
    a.out = (float*)d_out; a.ws = (unsigned char*)d_ws;
#if MK_PER_PHASE
    for (int ph = 0; ph < NPHASE; ++ph) { a.ph_lo = ph; a.ph_hi = ph + 1; hipLaunchKernelGGL(fwd_kernel, dim3(grid), dim3(512), LDS_BYTES, stream, a); }
#else
    a.ph_lo = 0; a.ph_hi = NPHASE;
    void* kargs[] = {&a};
    hipError_t e = hipLaunchCooperativeKernel((const void*)fwd_kernel, dim3(grid), dim3(512), kargs, LDS_BYTES, stream);
    if (e != hipSuccess) fprintf(stderr, "cooperative launch failed: %s (grid %d)\n", hipGetErrorString(e), grid);
#endif
}
```
